# Optimizing an MI355X kernel written in HIP

```python
import math
import jax, jax.numpy as jnp
from jax import lax
import numpy as np

D_MODEL = 1024
BATCH = 8
SEQ = 4096
DEPTH = 2

CHUNK = 64
Q_BLOCK = 128
RMS_EPS = 1e-6
ROPE_BASE = 10000.0

RET_HEADS = 8
RET_QK_DIM = D_MODEL // RET_HEADS
RET_V_DIM = 2 * RET_QK_DIM
RET_QK_WIDTH = RET_HEADS * RET_QK_DIM
RET_WIDTH = RET_HEADS * RET_V_DIM
RET_IN = 2 * RET_QK_WIDTH + 2 * RET_WIDTH

MLA_HEADS = 8
MLA_NOPE = 128
MLA_ROPE = 64
MLA_V = 128
MLA_WIDTH = MLA_HEADS * MLA_V
Q_LORA = 384
KV_LORA = 256
MLA_IN = Q_LORA + MLA_WIDTH

kernel_name = 'yoco_retention_mla_sandwich'


def rmsnorm(x, g):
    xf = x.astype(jnp.float32)
    y = xf * lax.rsqrt(jnp.mean(xf * xf, axis=-1, keepdims=True) + RMS_EPS)
    return (y * g.astype(jnp.float32)).astype(x.dtype)


def rope(x, pos):
    half = x.shape[-1] // 2
    inv = ROPE_BASE ** (-jnp.arange(half, dtype=jnp.float32) / half)
    ang = pos.astype(jnp.float32)[:, None] * inv[None, :]
    cos = jnp.cos(ang)[None, :, None, :].astype(x.dtype)
    sin = jnp.sin(ang)[None, :, None, :].astype(x.dtype)
    x1, x2 = x[..., :half], x[..., half:]
    return jnp.concatenate([x1 * cos - x2 * sin, x1 * sin + x2 * cos], axis=-1)


def retention_decays(dtype):
    log_g = jnp.log(1.0 - jnp.exp2(-5.0 - jnp.arange(RET_HEADS, dtype=jnp.float32)))
    idx = jnp.arange(CHUNK, dtype=jnp.float32)
    dist = jnp.abs(idx[:, None] - idx[None, :])
    inner = jnp.exp(log_g[:, None, None] * dist[None])
    xi = jnp.exp(log_g[:, None] * (idx + 1.0)[None])
    zeta = jnp.exp(log_g[:, None] * (CHUNK - 1.0 - idx)[None])
    g_c = jnp.exp(log_g * CHUNK)
    return inner.astype(dtype), xi.astype(dtype), zeta.astype(dtype), g_c.astype(dtype)


def retention_layer(x, g_pre, w_in, gn_gain, w_out, g_post):
    b, s, _ = x.shape
    nc = s // CHUNK
    h = rmsnorm(x, g_pre)
    proj = h @ w_in
    q, k, v, gate = jnp.split(proj, [RET_QK_WIDTH, 2 * RET_QK_WIDTH, 2 * RET_QK_WIDTH + RET_WIDTH], axis=-1)
    pos = jnp.arange(s)
    q = rope(q.reshape(b, s, RET_HEADS, RET_QK_DIM), pos)
    k = rope(k.reshape(b, s, RET_HEADS, RET_QK_DIM), pos) * (RET_QK_DIM ** -0.5)
    v = v.reshape(b, s, RET_HEADS, RET_V_DIM)

    def to_chunks(t):
        return t.reshape(b, nc, CHUNK, RET_HEADS, t.shape[-1]).transpose(1, 0, 3, 2, 4)

    qc, kc, vc = to_chunks(q), to_chunks(k), to_chunks(v)
    inner_dec, xi, zeta, g_c = retention_decays(x.dtype)
    scores = jnp.einsum('nbhcd,nbhmd->nbhcm', qc, kc) * inner_dec[None, None]
    inner = jnp.einsum('nbhcm,nbhme->nbhce', scores, vc)

    def step(R, inp):
        q_i, k_i, v_i = inp
        cross = jnp.einsum('bhcd,bhde->bhce', q_i, R) * xi[None, :, :, None]
        R = R * g_c[None, :, None, None] + jnp.einsum('bhcd,bhce->bhde', k_i * zeta[None, :, :, None], v_i)
        return R, cross

    R0 = jnp.zeros((b, RET_HEADS, RET_QK_DIM, RET_V_DIM), x.dtype)
    _, cross = lax.scan(step, R0, (qc, kc, vc))
    o = (inner + cross).transpose(1, 0, 3, 2, 4).reshape(b, s, RET_HEADS, RET_V_DIM)
    of = o.astype(jnp.float32)
    mu = jnp.mean(of, axis=-1, keepdims=True)
    var = jnp.mean(jnp.square(of - mu), axis=-1, keepdims=True)
    o = ((of - mu) * lax.rsqrt(var + RMS_EPS)).reshape(b, s, RET_WIDTH) * gn_gain.astype(jnp.float32)
    y = (jax.nn.silu(gate) * o.astype(x.dtype)) @ w_out
    return x + rmsnorm(y, g_post)


def shared_latent_kv(h, g_kv, w_kv_a, g_kv_lat, w_uk, w_uv):
    b, s, _ = h.shape
    src = rmsnorm(h, g_kv)
    a = src @ w_kv_a
    c_kv, k_r = a[..., :KV_LORA], a[..., KV_LORA:]
    c_kv = rmsnorm(c_kv, g_kv_lat)
    k_nope = (c_kv @ w_uk).reshape(b, s, MLA_HEADS, MLA_NOPE)
    v = (c_kv @ w_uv).reshape(b, s, MLA_HEADS, MLA_V)
    k_rope = rope(k_r[:, :, None, :], jnp.arange(s))[:, :, 0, :]
    return k_nope, k_rope, v


def mla_attention(q_nope, q_rope, k_nope, k_rope, v):
    b, s = q_nope.shape[:2]
    nb = s // Q_BLOCK
    qn = q_nope.reshape(b, nb, Q_BLOCK, MLA_HEADS, MLA_NOPE).transpose(1, 0, 2, 3, 4)
    qr = q_rope.reshape(b, nb, Q_BLOCK, MLA_HEADS, MLA_ROPE).transpose(1, 0, 2, 3, 4)
    k_chunk = jnp.arange(s) // CHUNK
    scale = (MLA_NOPE + MLA_ROPE) ** -0.5

    def block(args):
        qn_i, qr_i, i = args
        sc = jnp.einsum('bqhd,bkhd->bhqk', qn_i, k_nope) + jnp.einsum('bqhr,bkr->bhqk', qr_i, k_rope)
        sc = sc.astype(jnp.float32) * scale
        q_chunk = (i * Q_BLOCK + jnp.arange(Q_BLOCK)) // CHUNK
        mask = k_chunk[None, :] <= q_chunk[:, None]
        sc = jnp.where(mask[None, None], sc, -jnp.inf)
        p = jax.nn.softmax(sc, axis=-1).astype(v.dtype)
        return jnp.einsum('bhqk,bkhd->bqhd', p, v)

    out = lax.map(block, (qn, qr, jnp.arange(nb)))
    return out.transpose(1, 0, 2, 3, 4).reshape(b, s, MLA_WIDTH)


def mla_layer(x, g_pre, w_in, g_q_lat, w_uq, w_out, g_post, k_nope, k_rope, v):
    b, s, _ = x.shape
    h = rmsnorm(x, g_pre)
    proj = h @ w_in
    c_q, gate = proj[..., :Q_LORA], proj[..., Q_LORA:]
    q = (rmsnorm(c_q, g_q_lat) @ w_uq).reshape(b, s, MLA_HEADS, MLA_NOPE + MLA_ROPE)
    q_nope = q[..., :MLA_NOPE]
    q_rope = rope(q[..., MLA_NOPE:], jnp.arange(s))
    o = mla_attention(q_nope, q_rope, k_nope, k_rope, v)
    y = (jax.nn.silu(gate) * o) @ w_out
    return x + rmsnorm(y, g_post)


def setup_inputs(seed: int = 0) -> dict:
    key = jax.random.key(seed)
    ks = jax.random.split(key, 20)
    n_a = DEPTH // 2
    n_b = DEPTH - n_a
    f32 = jnp.float32

    def w(k, shape, fan_in):
        return jax.random.normal(k, shape, f32) * (fan_in ** -0.5)

    def gain(k, shape):
        return 1.0 + 0.02 * jax.random.normal(k, shape, f32)

    return {
        'x': jax.random.normal(ks[0], (BATCH, SEQ, D_MODEL), f32),
        'g_pre_a': gain(ks[1], (n_a, D_MODEL)),
        'w_in_a': w(ks[2], (n_a, D_MODEL, RET_IN), D_MODEL),
        'gn_gain_a': gain(ks[3], (n_a, RET_WIDTH)),
        'w_out_a': w(ks[4], (n_a, RET_WIDTH, D_MODEL), RET_WIDTH),
        'g_post_a': gain(ks[5], (n_a, D_MODEL)),
        'g_kv': gain(ks[6], (D_MODEL,)),
        'w_kv_a': w(ks[7], (D_MODEL, KV_LORA + MLA_ROPE), D_MODEL),
        'g_kv_lat': gain(ks[8], (KV_LORA,)),
        'w_uk': w(ks[9], (KV_LORA, MLA_HEADS * MLA_NOPE), KV_LORA),
        'w_uv': w(ks[10], (KV_LORA, MLA_WIDTH), KV_LORA),
        'g_pre_b': gain(ks[11], (n_b, D_MODEL)),
        'w_in_b': w(ks[12], (n_b, D_MODEL, MLA_IN), D_MODEL),
        'g_q_lat': gain(ks[13], (n_b, Q_LORA)),
        'w_uq': w(ks[14], (n_b, Q_LORA, MLA_HEADS * (MLA_NOPE + MLA_ROPE)), Q_LORA),
        'w_out_b': w(ks[15], (n_b, MLA_WIDTH, D_MODEL), MLA_WIDTH),
        'g_post_b': gain(ks[16], (n_b, D_MODEL)),
    }


def reference(x, g_pre_a, w_in_a, gn_gain_a, w_out_a, g_post_a, g_kv, w_kv_a, g_kv_lat, w_uk, w_uv,
              g_pre_b, w_in_b, g_q_lat, w_uq, w_out_b, g_post_b):
    n_a = w_in_a.shape[0]
    h = x
    k_nope = k_rope = v = None
    for layer in range(DEPTH):
        if layer < n_a:
            h = retention_layer(h, g_pre_a[layer], w_in_a[layer], gn_gain_a[layer], w_out_a[layer], g_post_a[layer])
        else:
            if layer == n_a:
                k_nope, k_rope, v = shared_latent_kv(h, g_kv, w_kv_a, g_kv_lat, w_uk, w_uv)
            j = layer - n_a
            h = mla_layer(h, g_pre_b[j], w_in_b[j], g_q_lat[j], w_uq[j], w_out_b[j], g_post_b[j], k_nope, k_rope, v)
    return h
```

```cpp
#include <hip/hip_runtime.h>
#include <hip/hip_cooperative_groups.h>
#include <cstdio>
#include <cstdint>
namespace cg = cooperative_groups;
namespace pg8 {
#define PG8_LAS __attribute__((address_space(3)))
typedef unsigned short bf16_t;
typedef short bf16x8 __attribute__((ext_vector_type(8)));
typedef float f32x4 __attribute__((ext_vector_type(4)));
typedef unsigned u32x4 __attribute__((ext_vector_type(4)));
constexpr int BM = 256, BK = 64, HALF = 128, HTB = HALF * BK * 2  , STAGE_BYTES = 8 * HTB, NXCD = 8, WGM = 8;

__host__ __device__ __forceinline__ int lds_byte(int r, int c) { const int st = (r >> 4) * 2 + (c >> 5), rr = r & 15, cc = c & 31, ob = rr * 64 + cc * 2; return st * 1024 + (ob ^ (((ob >> 9) & 1) << 5)); }
__host__ __device__ __forceinline__ void stage_rc(int b, int& R, int& C) { const int st = b / 1024, sb = b % 1024, swz = sb ^ (((sb >> 9) & 1) << 5); R = (st >> 1) * 16 + swz / 64; C = (st & 1) * 32 + (swz % 64) / 2; }
__host__ __device__ __forceinline__ int perm32(int rho) { const int n = rho >> 4, i = rho & 15; return 8 * (i >> 2) + 4 * n + (i & 3); }

struct Unit { int pm, pn; };
struct Gemm { const bf16_t* A; const bf16_t* Bt; int M, N, K; };

struct StaticOrder {
    int nM, nN, nwg, G, c;
    __host__ __device__ void init(int M, int N, int G_, int c_) { nM = M / BM; nN = N / BM; nwg = nM * nN; G = G_; c = c_; }
    __host__ __device__ bool next(int i, Unit& u) const {
        const long L = (long)i * G + c; if (L >= nwg) return false;
        int wgid = (int)L; { const int q = nwg / NXCD, r = nwg % NXCD, xcd = wgid % NXCD, off = wgid / NXCD; wgid = (xcd < r ? xcd * (q + 1) : r * (q + 1) + (xcd - r) * q) + off; }
        const int nig = WGM * nN, gid = wgid / nig, fm = gid * WGM, gsz = (nM - fm) < WGM ? (nM - fm) : WGM;
        u.pm = fm + ((wgid % nig) % gsz); u.pn = (wgid % nig) / gsz; return true;
    }
    __device__ __forceinline__ void a_ready(const Unit&) const {}
    __device__ __forceinline__ void done(const Unit&) const {}
};
typedef __bf16 bf16x2_t __attribute__((ext_vector_type(2)));
typedef float f32x2_t __attribute__((ext_vector_type(2)));
__device__ __forceinline__ unsigned cvt_pk_bf16(float lo, float hi) { f32x2_t v = {lo, hi}; bf16x2_t b = __builtin_convertvector(v, bf16x2_t); return __builtin_bit_cast(unsigned, b); }

template <class Epi, class Sched, bool ALIGN_EPI = false, bool SP2 = false>
__device__ __forceinline__ void gemm_phase(PG8_LAS unsigned char* lds, const Gemm g, const Sched& S, const Epi& E, const int tid) {
    const int wid = __builtin_amdgcn_readfirstlane(tid >> 6), lane = tid & 63, wr = wid >> 2, wc = wid & 3, fr = lane & 15, fq = lane >> 4;
    const int K = g.K, nt = K / BK;
    unsigned voffA[2], voffB[2];
#pragma unroll
    for (int i = 0; i < 2; ++i) { int R, C; stage_rc(tid * 16 + i * 8192, R, C); const int Rb = Epi::PERM ? ((R & ~31) + perm32(R & 31)) : R;
        voffA[i] = (unsigned)(R * K + C) * 2u; voffB[i] = (unsigned)(Rb * K + C) * 2u; }
    const size_t kstep = (size_t)(BK * 2);
    const size_t hstep = (size_t)HALF * K * 2;
    const size_t tstep = 2 * hstep;
    const unsigned ldsw = (unsigned)wid * 1024u;
    const int aoff = lds_byte(wr * 64 + fr, fq * 8), boff = lds_byte(wc * 32 + fr, fq * 8);
#define PG8_SA(b, h) (((b) * 2 + (h)) * HTB)
#define PG8_SB(b, h) ((4 + (b) * 2 + (h)) * HTB)
#define PG8_STAGE(bufoff, gbase, voff) do { _Pragma("unroll") for (int _i = 0; _i < 2; ++_i) \
        __builtin_amdgcn_global_load_lds((const unsigned*)((const char*)(gbase) + (voff)[_i]), (PG8_LAS unsigned*)(lds + (bufoff) + ldsw + _i * 8192), 16, 0, 0); } while (0)
#define PG8_LDA(dst, b, h) do { _Pragma("unroll") for (int m = 0; m < 4; ++m) _Pragma("unroll") for (int k = 0; k < 2; ++k) dst[m][k] = *(const PG8_LAS bf16x8*)(lds + PG8_SA(b, h) + aoff + m * 2048 + k * 1024); } while (0)
#define PG8_LDB(dst, b, h) do { _Pragma("unroll") for (int n = 0; n < 2; ++n) _Pragma("unroll") for (int k = 0; k < 2; ++k) dst[n][k] = *(const PG8_LAS bf16x8*)(lds + PG8_SB(b, h) + boff + n * 2048 + k * 1024); } while (0)
#define PG8_MMA(ai, bj, At, Bt) do { __builtin_amdgcn_s_setprio(1); _Pragma("unroll") for (int m = 0; m < 4; ++m) _Pragma("unroll") for (int n = 0; n < 2; ++n) _Pragma("unroll") for (int k = 0; k < 2; ++k) \
        acc[ai][bj][m][n] = __builtin_amdgcn_mfma_f32_16x16x32_bf16(Bt[n][k], At[m][k], acc[ai][bj][m][n], 0, 0, 0); __builtin_amdgcn_s_setprio(0); } while (0)
#define PG8_WAIT_V(n) asm volatile("s_waitcnt vmcnt(" #n ")" ::: "memory")
#define PG8_WAIT_L(n) asm volatile("s_waitcnt lgkmcnt(" #n ")" ::: "memory")
#define PG8_BAR __builtin_amdgcn_s_barrier()
#define PG8_SCHED __builtin_amdgcn_sched_barrier(0)
    Unit cur, nxt; int ui = 0;
    if (!S.next(0, cur)) return;
    f32x4 acc[2][2][4][2];
#pragma unroll
    for (int a = 0; a < 2; ++a)
#pragma unroll
        for (int b = 0; b < 2; ++b)
#pragma unroll
            for (int m = 0; m < 4; ++m)
#pragma unroll
                for (int n = 0; n < 2; ++n) acc[a][b][m][n] = (f32x4){0.f, 0.f, 0.f, 0.f};
    bf16x8 At[4][2], B0[2][2], B1[2][2];
    const char* cA = (const char*)g.A + (size_t)cur.pm * tstep; const char* cB = (const char*)g.Bt + (size_t)cur.pn * tstep;
    S.a_ready(cur);
    if constexpr (SP2) {
        PG8_STAGE(PG8_SB(0, 0), cB, voffB); PG8_STAGE(PG8_SB(0, 1), cB + hstep, voffB); PG8_STAGE(PG8_SA(0, 0), cA, voffA); PG8_STAGE(PG8_SA(0, 1), cA + hstep, voffA);
        if (wr == 1) PG8_BAR;
        PG8_WAIT_V(2); PG8_BAR;
        PG8_STAGE(PG8_SB(1, 0), cB + kstep, voffB); PG8_STAGE(PG8_SA(1, 0), cA + kstep, voffA); PG8_STAGE(PG8_SB(1, 1), cB + hstep + kstep, voffB);
        PG8_WAIT_V(6); PG8_BAR;
    } else {
        PG8_STAGE(PG8_SB(0, 0), cB, voffB); PG8_STAGE(PG8_SA(0, 0), cA, voffA); PG8_STAGE(PG8_SB(0, 1), cB + hstep, voffB); PG8_STAGE(PG8_SA(0, 1), cA + hstep, voffA);
        if (wr == 1) PG8_BAR;
        PG8_WAIT_V(4); PG8_BAR;
        PG8_STAGE(PG8_SB(1, 0), cB + kstep, voffB); PG8_STAGE(PG8_SA(1, 0), cA + kstep, voffA); PG8_STAGE(PG8_SB(1, 1), cB + hstep + kstep, voffB);
        PG8_WAIT_V(6); PG8_BAR;
    }
    for (;;) {
        const bool has_next = S.next(ui + 1, nxt);
        const char* nA = has_next ? (const char*)g.A + (size_t)nxt.pm * tstep : cA; const char* nB = has_next ? (const char*)g.Bt + (size_t)nxt.pn * tstep : cB;
        for (int t = 0; t < nt; t += 2) {
            const bool last = (t == nt - 2);
            const char* a1 = cA + (size_t)(t + 1) * kstep;
            const char* a2 = last ? nA : cA + (size_t)(t + 2) * kstep; const char* b2 = last ? nB : cB + (size_t)(t + 2) * kstep;
            const char* a3 = a2 + kstep; const char* b3 = b2 + kstep;
            if (last && has_next) S.a_ready(nxt);
            if constexpr (SP2) {
            PG8_LDB(B0, 0, 0); PG8_LDB(B1, 0, 1); PG8_SCHED; PG8_LDA(At, 0, 0); PG8_STAGE(PG8_SA(1, 1), a1 + hstep, voffA);
            PG8_WAIT_V(8); PG8_WAIT_L(0); PG8_BAR; PG8_MMA(0, 0, At, B0); PG8_MMA(0, 1, At, B1); PG8_BAR; PG8_SCHED;
            PG8_LDA(At, 0, 1); PG8_STAGE(PG8_SB(0, 0), b2, voffB); PG8_STAGE(PG8_SB(0, 1), b2 + hstep, voffB); PG8_STAGE(PG8_SA(0, 0), a2, voffA);
            PG8_WAIT_V(8); PG8_WAIT_L(0); PG8_BAR; PG8_MMA(1, 0, At, B0); PG8_MMA(1, 1, At, B1); PG8_BAR; PG8_SCHED;
            PG8_LDB(B0, 1, 0); PG8_LDB(B1, 1, 1); PG8_SCHED; PG8_LDA(At, 1, 0); PG8_STAGE(PG8_SA(0, 1), a2 + hstep, voffA);
            PG8_WAIT_V(8); PG8_WAIT_L(0); PG8_BAR; PG8_MMA(0, 0, At, B0); PG8_MMA(0, 1, At, B1); PG8_BAR; PG8_SCHED;
            PG8_LDA(At, 1, 1); PG8_STAGE(PG8_SB(1, 0), b3, voffB); PG8_STAGE(PG8_SB(1, 1), b3 + hstep, voffB); PG8_STAGE(PG8_SA(1, 0), a3, voffA);
            PG8_WAIT_V(8); PG8_WAIT_L(0); PG8_BAR; PG8_MMA(1, 0, At, B0); PG8_MMA(1, 1, At, B1); PG8_BAR; PG8_SCHED;
            } else {
            PG8_LDB(B0, 0, 0); PG8_SCHED; PG8_LDA(At, 0, 0); PG8_STAGE(PG8_SA(1, 1), a1 + hstep, voffA);
            PG8_WAIT_L(8); PG8_BAR; PG8_WAIT_L(0); PG8_MMA(0, 0, At, B0); PG8_BAR; PG8_SCHED;
            PG8_LDB(B1, 0, 1); PG8_STAGE(PG8_SB(0, 0), b2, voffB);
            PG8_BAR; PG8_WAIT_L(0); PG8_MMA(0, 1, At, B1); PG8_BAR;
            PG8_LDA(At, 0, 1); PG8_STAGE(PG8_SA(0, 0), a2, voffA);
            PG8_BAR; PG8_WAIT_L(0); PG8_MMA(1, 0, At, B0); PG8_BAR; PG8_SCHED;
            PG8_STAGE(PG8_SB(0, 1), b2 + hstep, voffB);
            PG8_WAIT_V(6); PG8_BAR; PG8_MMA(1, 1, At, B1); PG8_BAR;
            PG8_LDB(B0, 1, 0); PG8_SCHED; PG8_LDA(At, 1, 0); PG8_STAGE(PG8_SA(0, 1), a2 + hstep, voffA);
            PG8_WAIT_L(8); PG8_BAR; PG8_WAIT_L(0); PG8_MMA(0, 0, At, B0); PG8_BAR; PG8_SCHED;
            PG8_LDB(B1, 1, 1); PG8_STAGE(PG8_SB(1, 0), b3, voffB);
            PG8_BAR; PG8_WAIT_L(0); PG8_MMA(0, 1, At, B1); PG8_BAR;
            PG8_LDA(At, 1, 1); PG8_STAGE(PG8_SA(1, 0), a3, voffA);
            PG8_BAR; PG8_WAIT_L(0); PG8_MMA(1, 0, At, B0); PG8_BAR; PG8_SCHED;
            PG8_STAGE(PG8_SB(1, 1), b3 + hstep, voffB);
            PG8_WAIT_V(6); PG8_BAR; PG8_MMA(1, 1, At, B1); PG8_BAR;
            }
        }
        if constexpr (ALIGN_EPI) { if (wr == 0) PG8_BAR; }
        if constexpr (!Epi::AFTER_DRAIN) { E(acc, cur, wr, wc, fr, fq); S.done(cur); }
        if (!has_next) break;
#pragma unroll
        for (int a = 0; a < 2; ++a)
#pragma unroll
            for (int b = 0; b < 2; ++b)
#pragma unroll
                for (int m = 0; m < 4; ++m)
#pragma unroll
                    for (int n = 0; n < 2; ++n) acc[a][b][m][n] = (f32x4){0.f, 0.f, 0.f, 0.f};
        cur = nxt; cA = nA; cB = nB; ++ui;
        if constexpr (ALIGN_EPI) { if (wr == 1) PG8_BAR; }
    }
    PG8_WAIT_V(0);
    if constexpr (!ALIGN_EPI) { if (wr == 0) PG8_BAR; }
    PG8_BAR;
    if constexpr (Epi::AFTER_DRAIN) { E.fused(acc, cur, wr, wc, fr, fq, lds, wid, lane); S.done(cur); }
#undef PG8_SA
#undef PG8_SB
#undef PG8_STAGE
#undef PG8_LDA
#undef PG8_LDB
#undef PG8_MMA
#undef PG8_WAIT_V
#undef PG8_WAIT_L
#undef PG8_BAR
#undef PG8_SCHED
}
}

#define LAS __attribute__((address_space(3)))
typedef unsigned short bf16_t;
typedef short bf16x8 __attribute__((ext_vector_type(8)));
typedef short s16x4 __attribute__((ext_vector_type(4)));
typedef float f32x4 __attribute__((ext_vector_type(4)));
typedef float f32x2 __attribute__((ext_vector_type(2)));
typedef float f32x16 __attribute__((ext_vector_type(16)));
typedef unsigned u32x4 __attribute__((ext_vector_type(4)));
typedef unsigned u32x2 __attribute__((ext_vector_type(2)));
using pg8::Unit;

constexpr int NWAVES = 8, NTHREADS = 512;
constexpr int SEQ = 4096, DM = 1024, MTOK = 8 * SEQ;
constexpr int N1 = 6144, N3 = 1792, QROW = 1536;
constexpr float RMS_EPS = 1e-6f;
constexpr int LDS_BYTES = 163840;

constexpr size_t MiB = 1u << 20;
constexpr size_t WS_CTL = 0, WS_TABA = 1 * MiB, WS_TABB = 3 * MiB;
constexpr size_t WS_W1 = 4 * MiB, WS_W2 = 16 * MiB, WS_W3 = 20 * MiB, WS_WUQ = 24 * MiB, WS_WKV = 26 * MiB, WS_W5 = 27 * MiB;
constexpr size_t WS_XN = 32 * MiB, WS_Q = 96 * MiB, WS_K = 160 * MiB, WS_V = 224 * MiB, WS_G = 352 * MiB, WS_L = 480 * MiB;
constexpr size_t WS_Y1 = WS_Q, WS_H1 = WS_V, WS_XN2 = WS_XN, WS_SG2 = WS_K;
constexpr size_t WS_CQ = 352 * MiB, WS_CKV = 376 * MiB, WS_KRR = 392 * MiB, WS_PQ = 400 * MiB, WS_PKV = 402 * MiB, WS_KR = 404 * MiB, WS_QM = 408 * MiB;
constexpr size_t WS_KN = WS_XN, WS_V2 = WS_Q, WS_Y2 = WS_XN;
constexpr size_t WS_NEED = 512 * MiB;

struct Args { const float* in[17]; float* out; unsigned char* ws; int ph_lo, ph_hi; };

__device__ __forceinline__ unsigned pk2(float lo, float hi) { return pg8::cvt_pk_bf16(lo, hi); }
__device__ __forceinline__ float bf_lo(unsigned w) { return __uint_as_float(w << 16); }
__device__ __forceinline__ float bf_hi(unsigned w) { return __uint_as_float(w & 0xffff0000u); }
__device__ __forceinline__ float bf1(bf16_t v) { return __uint_as_float(((unsigned)v) << 16); }
__device__ __forceinline__ float wave_sum(float v) {
#pragma unroll
    for (int o = 1; o < 64; o <<= 1) v += __shfl_xor(v, o);
    return v;
}
__device__ __forceinline__ float silu_f(float x) { return x * __builtin_amdgcn_rcpf(1.0f + __expf(-x)); }
__device__ __forceinline__ int crow(int r, int hi) { return (r & 3) + 8 * (r >> 2) + 4 * hi; }
#define LDS_WAIT() asm volatile("s_waitcnt lgkmcnt(0)" ::: "memory")
#define SBAR() __builtin_amdgcn_sched_barrier(0)

__device__ __forceinline__ void p0_item(const float* __restrict__ W, int N, int K, const float* __restrict__ gain, bf16_t* WT, int k0, int sc, int n0, LAS float* scr, int lane) {
    if (sc >= 0) {
        float wv[32], gv[32];
#pragma unroll
        for (int i = 0; i < 32; ++i) { const int kk = 2 * i + (lane >> 5); wv[i] = W[(size_t)(k0 + kk) * N + sc + (lane & 31)]; gv[i] = gain ? gain[k0 + kk] : 1.0f; }
#pragma unroll
        for (int i = 0; i < 32; ++i) { const int kk = 2 * i + (lane >> 5); scr[kk * 33 + (lane & 31)] = wv[i] * gv[i]; }
    } else {
#pragma unroll 8
        for (int i = 0; i < 32; ++i) { const int kk = 2 * i + (lane >> 5); scr[kk * 33 + (lane & 31)] = 0.0f; }
    }
    LDS_WAIT(); asm volatile("" ::: "memory");
    const int c = lane & 7;
#pragma unroll
    for (int j = 0; j < 4; ++j) { const int n = (lane >> 3) + 8 * j; const LAS float* s = scr + (8 * c) * 33 + n;
        u32x4 o; o.x = pk2(s[0 * 33], s[1 * 33]); o.y = pk2(s[2 * 33], s[3 * 33]); o.z = pk2(s[4 * 33], s[5 * 33]); o.w = pk2(s[6 * 33], s[7 * 33]);
        *(u32x4*)(WT + (size_t)(n0 + n) * K + k0 + 8 * c) = o; }
    LDS_WAIT(); asm volatile("" ::: "memory");
}
__device__ __forceinline__ void p0_prologue(const Args& a, LAS unsigned char* lds, int gw, int NGW, int wave, int lane) {
    unsigned char* ws = a.ws;
    LAS float* scr = (LAS float*)(lds + wave * 16384);
    constexpr int I1 = 16 * 192, I2 = 32 * 32, I3 = 16 * 56, I4 = 6 * 48, I5 = 4 * 64, I6 = 16 * 32;
    for (int it = gw; it < I1 + I2 + I3 + I4 + I5 + I6; it += NGW) {
        int r = it;
        if (r < I1) {
            const int kb = r / 192, n = 32 * (r % 192); int sc;
            if (n < 2048) { const int region = n >> 10, tq = (n & 1023) >> 8, j = n & 255, head = 2 * tq + ((j >> 6) & 1), d = (j & 63) + 64 * (j >> 7); sc = region * 1024 + head * 128 + d; } else sc = n;
            p0_item(a.in[2], 6144, 1024, a.in[1], (bf16_t*)(ws + WS_W1), kb * 64, sc, n, scr, lane); continue; }
        r -= I1;
        if (r < I2) {
            const int kb = r / 32, n = 32 * (r % 32);
            p0_item(a.in[4], 1024, 2048, a.in[3], (bf16_t*)(ws + WS_W2), kb * 64, n, n, scr, lane); continue; }
        r -= I2;
        if (r < I3) {
            const int kb = r / 56, n = 32 * (r % 56);
            if (n < 1024)      p0_item(a.in[12], 1408, 1024, a.in[11], (bf16_t*)(ws + WS_W3), kb * 64, 384 + n, n, scr, lane);
            else if (n < 1408) p0_item(a.in[12], 1408, 1024, a.in[11], (bf16_t*)(ws + WS_W3), kb * 64, n - 1024, n, scr, lane);
            else if (n < 1664) p0_item(a.in[7], 320, 1024, a.in[6], (bf16_t*)(ws + WS_W3), kb * 64, n - 1408, n, scr, lane);
            else if (n < 1728) p0_item(a.in[7], 320, 1024, a.in[6], (bf16_t*)(ws + WS_W3), kb * 64, 256 + (n - 1664), n, scr, lane);
            else               p0_item(a.in[7], 320, 1024, a.in[6], (bf16_t*)(ws + WS_W3), kb * 64, -1, n, scr, lane);
            continue; }
        r -= I3;
        if (r < I4) {
            const int kb = r / 48, n = 32 * (r % 48); const int sc = n;
            p0_item(a.in[14], 1536, 384, a.in[13], (bf16_t*)(ws + WS_WUQ), kb * 64, sc, n, scr, lane); continue; }
        r -= I4;
        if (r < I5) {
            const int kb = r / 64, n = 32 * (r % 64);
            if (n < 1024) p0_item(a.in[9], 1024, 256, a.in[8], (bf16_t*)(ws + WS_WKV), kb * 64, n, n, scr, lane);
            else          p0_item(a.in[10], 1024, 256, a.in[8], (bf16_t*)(ws + WS_WKV), kb * 64, n - 1024, n, scr, lane);
            continue; }
        r -= I5;
        { const int kb = r / 32, n = 32 * (r % 32);
          p0_item(a.in[15], 1024, 1024, nullptr, (bf16_t*)(ws + WS_W5), kb * 64, n, n, scr, lane); }
    }
    {
        f32x2* tA = (f32x2*)(ws + WS_TABA); f32x2* tB = (f32x2*)(ws + WS_TABB);
        const int gt = gw * 64 + lane, NT = NGW * 64;
        for (int i = gt; i < 4096 * 64; i += NT) { const int pos = i >> 6, d = i & 63; const float inv = powf(10000.0f, -(float)d / 64.0f); float s, c; sincosf((float)pos * inv, &s, &c); tA[i] = (f32x2){c, s}; }
        for (int i = gt; i < 4096 * 32; i += NT) { const int pos = i >> 5, d = i & 31; const float inv = powf(10000.0f, -(float)d / 32.0f); float s, c; sincosf((float)pos * inv, &s, &c); tB[i] = (f32x2){c, s}; }
    }
    {
        const float* x = a.in[0]; bf16_t* xn = (bf16_t*)(ws + WS_XN);
        for (int m = gw; m < MTOK; m += NGW) {
            const f32x4* xr = (const f32x4*)(x + (size_t)m * DM) + lane; f32x4 v[4]; float s = 0.f;
#pragma unroll
            for (int j = 0; j < 4; ++j) { v[j] = xr[64 * j]; s += (v[j].x * v[j].x + v[j].y * v[j].y) + (v[j].z * v[j].z + v[j].w * v[j].w); }
            const float rs = 1.0f / sqrtf(wave_sum(s) * (1.0f / DM) + RMS_EPS);
            u32x2* o = (u32x2*)(xn + (size_t)m * DM) + lane;
#pragma unroll
            for (int j = 0; j < 4; ++j) { u32x2 w; w.x = pk2(v[j].x * rs, v[j].y * rs); w.y = pk2(v[j].z * rs, v[j].w * rs); o[64 * j] = w; }
        }
    }
}

__device__ __forceinline__ u32x4 pack8(const f32x4 a, const f32x4 b) { u32x4 w; w.x = pk2(a[0], a[1]); w.y = pk2(a[2], a[3]); w.z = pk2(b[0], b[1]); w.w = pk2(b[2], b[3]); return w; }

struct EpiP1 {
    static constexpr bool PERM = true, AFTER_DRAIN = false;
    bf16_t *q, *k, *v, *sg; const f32x4* tabA;
    __device__ __forceinline__ void operator()(const f32x4 (&acc)[2][2][4][2], const Unit& u, int wr, int wc, int fr, int fq) const {
        const int pn = u.pn, row0 = u.pm * 256 + wr * 64 + fr;
        if (pn < 8) {
            const int region = pn >> 2, tq = pn & 3, head = 2 * tq + (wc >> 1), d0 = 32 * (wc & 1) + 8 * fq;
            bf16_t* dst = region ? k : q;
            const float l2g = log2f(1.0f - exp2f(-5.0f - (float)head));
            f32x4 tn[4];
            { const f32x4* tp = tabA + ((size_t)(row0 & 4095) * 64 + d0) / 2; tn[0] = tp[0]; tn[1] = tp[1]; tn[2] = tp[2]; tn[3] = tp[3]; }
#pragma unroll
            for (int idx = 0; idx < 8; ++idx) {
                const int ai = idx >> 2, m = idx & 3;
                int row = row0 + ai * 128 + m * 16; asm volatile("" : "+v"(row)); const int n = row & 63;
                const f32x4 t0 = tn[0], t1 = tn[1], t2 = tn[2], t3 = tn[3];
                if (idx < 7) { const int nrow = row0 + ((idx + 1) >> 2) * 128 + ((idx + 1) & 3) * 16; const f32x4* tp = tabA + ((size_t)(nrow & 4095) * 64 + d0) / 2; tn[0] = tp[0]; tn[1] = tp[1]; tn[2] = tp[2]; tn[3] = tp[3]; }
                const float sc = region ? 0.08838834764831845f * exp2f(l2g * (float)(63 - n)) : exp2f(l2g * (float)(n + 1));
                const f32x4 xa = acc[ai][0][m][0], xb = acc[ai][0][m][1], ya = acc[ai][1][m][0], yb = acc[ai][1][m][1];
                f32x4 oa, ob, pa, pb;
                oa[0] = (xa[0] * t0[0] - ya[0] * t0[1]) * sc; pa[0] = (xa[0] * t0[1] + ya[0] * t0[0]) * sc;
                oa[1] = (xa[1] * t0[2] - ya[1] * t0[3]) * sc; pa[1] = (xa[1] * t0[3] + ya[1] * t0[2]) * sc;
                oa[2] = (xa[2] * t1[0] - ya[2] * t1[1]) * sc; pa[2] = (xa[2] * t1[1] + ya[2] * t1[0]) * sc;
                oa[3] = (xa[3] * t1[2] - ya[3] * t1[3]) * sc; pa[3] = (xa[3] * t1[3] + ya[3] * t1[2]) * sc;
                ob[0] = (xb[0] * t2[0] - yb[0] * t2[1]) * sc; pb[0] = (xb[0] * t2[1] + yb[0] * t2[0]) * sc;
                ob[1] = (xb[1] * t2[2] - yb[1] * t2[3]) * sc; pb[1] = (xb[1] * t2[3] + yb[1] * t2[2]) * sc;
                ob[2] = (xb[2] * t3[0] - yb[2] * t3[1]) * sc; pb[2] = (xb[2] * t3[1] + yb[2] * t3[0]) * sc;
                ob[3] = (xb[3] * t3[2] - yb[3] * t3[3]) * sc; pb[3] = (xb[3] * t3[3] + yb[3] * t3[2]) * sc;
                bf16_t* rp = dst + (size_t)row * 1024 + head * 128 + d0;
                *(u32x4*)rp = pack8(oa, ob); *(u32x4*)(rp + 64) = pack8(pa, pb);
            }
        } else {
            bf16_t* dstb = (pn < 16) ? v : sg; const int col0 = ((pn - 8) & 7) * 256 + wc * 32 + 8 * fq;
#pragma unroll
            for (int ai = 0; ai < 2; ++ai)
#pragma unroll
                for (int m = 0; m < 4; ++m) { bf16_t* rp = dstb + (size_t)(row0 + ai * 128 + m * 16) * 2048 + col0;
#pragma unroll
                    for (int bj = 0; bj < 2; ++bj) *(u32x4*)(rp + bj * 128) = pack8(acc[ai][bj][m][0], acc[ai][bj][m][1]); }
        }
    }
};

struct EpiPlain {
    static constexpr bool PERM = true, AFTER_DRAIN = false;
    bf16_t* O; int ldc;
    __device__ __forceinline__ void operator()(const f32x4 (&acc)[2][2][4][2], const Unit& u, int wr, int wc, int fr, int fq) const {
        const int row0 = u.pm * 256 + wr * 64 + fr, col0 = u.pn * 256 + wc * 32 + 8 * fq;
#pragma unroll
        for (int ai = 0; ai < 2; ++ai)
#pragma unroll
            for (int m = 0; m < 4; ++m) { bf16_t* rp = O + (size_t)(row0 + ai * 128 + m * 16) * ldc + col0;
#pragma unroll
                for (int bj = 0; bj < 2; ++bj) *(u32x4*)(rp + bj * 128) = pack8(acc[ai][bj][m][0], acc[ai][bj][m][1]); }
    }
};

struct EpiP4 {
    static constexpr bool PERM = true, AFTER_DRAIN = false;
    bf16_t *sg2, *cq, *ckv; float *krr, *pq, *pkv;
    __device__ __forceinline__ void operator()(const f32x4 (&acc)[2][2][4][2], const Unit& u, int wr, int wc, int fr, int fq) const {
        const int row0 = u.pm * 256 + wr * 64 + fr, c0 = wc * 32 + 8 * fq;
#pragma unroll
        for (int bj = 0; bj < 2; ++bj) {
            const int hh = 2 * u.pn + bj;
            if (hh < 8) {
#pragma unroll
                for (int ai = 0; ai < 2; ++ai)
#pragma unroll
                    for (int m = 0; m < 4; ++m) *(u32x4*)(sg2 + (size_t)(row0 + ai * 128 + m * 16) * 1024 + hh * 128 + c0) = pack8(acc[ai][bj][m][0], acc[ai][bj][m][1]);
            } else if (hh < 13) {
                const bool isq = hh < 11; const int hq = isq ? hh - 8 : hh - 11, ld = isq ? 384 : 256, nslot = isq ? 12 : 8;
                bf16_t* dst = isq ? cq : ckv; float* pp = isq ? pq : pkv;
#pragma unroll
                for (int ai = 0; ai < 2; ++ai)
#pragma unroll
                    for (int m = 0; m < 4; ++m) { int row = row0 + ai * 128 + m * 16; asm volatile("" : "+v"(row)); const f32x4 a0 = acc[ai][bj][m][0], a1 = acc[ai][bj][m][1];
                        *(u32x4*)(dst + (size_t)row * ld + hq * 128 + c0) = pack8(a0, a1);
                        float s = (a0[0] * a0[0] + a0[1] * a0[1]) + (a0[2] * a0[2] + a0[3] * a0[3]) + (a1[0] * a1[0] + a1[1] * a1[1]) + (a1[2] * a1[2] + a1[3] * a1[3]);
                        s += __shfl_xor(s, 16); s += __shfl_xor(s, 32);
                        if (fq == 0) pp[(size_t)row * nslot + hq * 4 + wc] = s; }
            } else {
                if (wc < 2) {
#pragma unroll
                    for (int ai = 0; ai < 2; ++ai)
#pragma unroll
                        for (int m = 0; m < 4; ++m) { float* rp = krr + (size_t)(row0 + ai * 128 + m * 16) * 64 + c0;
                            *(f32x4*)rp = acc[ai][bj][m][0]; *(f32x4*)(rp + 4) = acc[ai][bj][m][1]; }
                }
            }
        }
    }
};

struct EpiP5kv {
    static constexpr bool PERM = true, AFTER_DRAIN = false;
    bf16_t *kn, *v2; const float* pkv;
    __device__ __forceinline__ void operator()(const f32x4 (&acc)[2][2][4][2], const Unit& u, int wr, int wc, int fr, int fq) const {
        const int row0 = u.pm * 256 + wr * 64 + fr; bf16_t* dst = (u.pn < 4) ? kn : v2; const int col0 = (u.pn & 3) * 256 + wc * 32 + 8 * fq;
#pragma unroll
        for (int ai = 0; ai < 2; ++ai) {
            float rsv[4];
#pragma unroll
            for (int m = 0; m < 4; ++m) { const int row = row0 + ai * 128 + m * 16; const f32x4* pp = (const f32x4*)(pkv + (size_t)row * 8);
                const f32x4 p0 = pp[0], p1 = pp[1];
                const float ss = ((p0[0] + p0[1]) + (p0[2] + p0[3])) + ((p1[0] + p1[1]) + (p1[2] + p1[3]));
                rsv[m] = 1.0f / sqrtf(ss * (1.0f / 256.0f) + RMS_EPS); }
#pragma unroll
            for (int m = 0; m < 4; ++m) {
                int row = row0 + ai * 128 + m * 16; asm volatile("" : "+v"(row));
                bf16_t* rp = dst + (size_t)row * 1024 + col0; const float rs = rsv[m];
#pragma unroll
                for (int bj = 0; bj < 2; ++bj) *(u32x4*)(rp + bj * 128) = pack8(acc[ai][bj][m][0] * rs, acc[ai][bj][m][1] * rs);
            }
            asm volatile("" ::: "memory");
        }
    }
};

template <bool BASE_BF16, bool OUT_BF16, bool WITH_XN>
__device__ __forceinline__ void row_phase(const bf16_t* __restrict__ y, const void* __restrict__ base, const float* __restrict__ gpost, void* outp, bf16_t* xn, int gw, int NGW, int lane) {
    f32x4 g[2][2];
#pragma unroll
    for (int j = 0; j < 2; ++j) { const f32x4* gp = (const f32x4*)(gpost + 8 * lane + 512 * j); g[j][0] = gp[0]; g[j][1] = gp[1]; }
    for (int m0 = gw; m0 < MTOK; m0 += 2 * NGW) {
        u32x4 yw[2][2]; float xb[2][2][8];
#pragma unroll
        for (int r = 0; r < 2; ++r) { const int m = m0 + r * NGW;
#pragma unroll
            for (int j = 0; j < 2; ++j) { const size_t off = (size_t)m * DM + 8 * lane + 512 * j;
                yw[r][j] = *(const u32x4*)(y + off);
                if (BASE_BF16) { const u32x4 bw = *(const u32x4*)((const bf16_t*)base + off);
#pragma unroll
                    for (int q = 0; q < 4; ++q) { xb[r][j][2 * q] = bf_lo(bw[q]); xb[r][j][2 * q + 1] = bf_hi(bw[q]); } }
                else { const f32x4* bp = (const f32x4*)((const float*)base + off); const f32x4 b0 = bp[0], b1 = bp[1];
#pragma unroll
                    for (int q = 0; q < 4; ++q) { xb[r][j][q] = b0[q]; xb[r][j][4 + q] = b1[q]; } } } }
#pragma unroll
        for (int r = 0; r < 2; ++r) { const int m = m0 + r * NGW;
            float yv[2][8]; float s = 0.f;
#pragma unroll
            for (int j = 0; j < 2; ++j) {
#pragma unroll
                for (int q = 0; q < 4; ++q) { yv[j][2 * q] = bf_lo(yw[r][j][q]); yv[j][2 * q + 1] = bf_hi(yw[r][j][q]); }
#pragma unroll
                for (int q = 0; q < 8; ++q) s += yv[j][q] * yv[j][q]; }
            const float rs = 1.0f / sqrtf(wave_sum(s) * (1.0f / DM) + RMS_EPS);
            float hv[2][8]; float s2 = 0.f;
#pragma unroll
            for (int j = 0; j < 2; ++j)
#pragma unroll
                for (int q = 0; q < 8; ++q) { hv[j][q] = xb[r][j][q] + yv[j][q] * rs * g[j][q >> 2][q & 3]; s2 += hv[j][q] * hv[j][q]; }
#pragma unroll
            for (int j = 0; j < 2; ++j) { const size_t off = (size_t)m * DM + 8 * lane + 512 * j;
                if (OUT_BF16) { u32x4 w; w.x = pk2(hv[j][0], hv[j][1]); w.y = pk2(hv[j][2], hv[j][3]); w.z = pk2(hv[j][4], hv[j][5]); w.w = pk2(hv[j][6], hv[j][7]); *(u32x4*)((bf16_t*)outp + off) = w; }
                else { f32x4* op = (f32x4*)((float*)outp + off); op[0] = (f32x4){hv[j][0], hv[j][1], hv[j][2], hv[j][3]}; op[1] = (f32x4){hv[j][4], hv[j][5], hv[j][6], hv[j][7]}; } }
            if (WITH_XN) {
                const float rs2 = 1.0f / sqrtf(wave_sum(s2) * (1.0f / DM) + RMS_EPS);
#pragma unroll
                for (int j = 0; j < 2; ++j) { u32x4 w; w.x = pk2(hv[j][0] * rs2, hv[j][1] * rs2); w.y = pk2(hv[j][2] * rs2, hv[j][3] * rs2); w.z = pk2(hv[j][4] * rs2, hv[j][5] * rs2); w.w = pk2(hv[j][6] * rs2, hv[j][7] * rs2);
                    *(u32x4*)(xn + (size_t)m * DM + 8 * lane + 512 * j) = w; }
            }
        }
    }
}

namespace ret {
constexpr int QS_STRIDE = 272, KS_STRIDE = 320, VS_STRIDE = 576, RT_STRIDE = 272, SS_STRIDE = 144, OS_STRIDE = 528;
constexpr int R_QS = 0, R_KS = 17408, R_VS = 37888, R_RT = 74752, R_SS = 144384, R_ST = 153600, R_END = 157696, R_OS = 0;
static_assert(R_END <= LDS_BYTES && 64 * OS_STRIDE <= R_VS, "retention LDS map");

__device__ __forceinline__ s16x4 trr(unsigned addr) { s16x4 r; asm volatile("ds_read_b64_tr_b16 %0, %1" : "=&v"(r) : "v"(addr) : "memory"); return r; }
#define RET_PK(L, H) (bf16x8){L[0], L[1], L[2], L[3], H[0], H[1], H[2], H[3]}
#define MFMA32(a, b, c) __builtin_amdgcn_mfma_f32_32x32x16_bf16((a), (b), (c), 0, 0, 0)

template <bool PRE>
__device__ __forceinline__ void ret_item(LAS unsigned char* lds, const bf16_t* __restrict__ Qg, const bf16_t* __restrict__ Kg, const bf16_t* __restrict__ Vg, bf16_t* SGg, float* Lbuf,
                                         int bh, int g, int tid_in, int wid, int lane_in, bf16_t* OUTg, int rowmask) {
    const int b = bh >> 3, h = bh & 7;
    const float l2g = log2f(1.0f - exp2f(-5.0f - (float)h));
    const float gc = exp2f(l2g * 64.0f);
    const int tok_seg0 = b * SEQ + g * 1024;
    const unsigned ldsb = (unsigned)(size_t)lds;
    f32x16 R[4];
#pragma unroll
    for (int dt = 0; dt < 4; ++dt)
#pragma unroll
        for (int r = 0; r < 16; ++r) R[dt][r] = 0.f;
    if (!PRE) {
        const int lane = lane_in, r32 = lane & 31, hi = lane >> 5;
        if (g > 0) {
            const float c16 = exp2f(l2g * 1024.0f); float coef = 1.0f;
            for (int gp = g - 1; gp >= 0; --gp) {
                const float* lp = Lbuf + ((size_t)(bh * 3 + gp) * 8 + wid) * 4096 + lane;
#pragma unroll
                for (int dt = 0; dt < 4; ++dt)
#pragma unroll
                    for (int r = 0; r < 16; ++r) R[dt][r] += coef * lp[(dt * 16 + r) * 64];
                coef *= c16;
            }
        }
#pragma unroll
        for (int dt = 0; dt < 4; ++dt)
#pragma unroll
            for (int gq = 0; gq < 4; ++gq) { u32x2 w; w.x = pk2(R[dt][4 * gq], R[dt][4 * gq + 1]); w.y = pk2(R[dt][4 * gq + 2], R[dt][4 * gq + 3]);
                *(LAS u32x2*)(lds + R_RT + (32 * wid + r32) * RT_STRIDE + (32 * dt + 8 * gq + 4 * hi) * 2) = w; }
    }
    u32x4 sq[2], sk[2], sv[4];
#define RET_LOAD(tok0) do { \
        _Pragma("unroll") for (int j_ = 0; j_ < 2; ++j_) { const int c = tid + 512 * j_, row = c >> 4, ch = c & 15; \
            if (!PRE) sq[j_] = *(const u32x4*)(Qg + (size_t)((tok0) + row) * 1024 + h * 128 + ch * 8); \
            sk[j_] = *(const u32x4*)(Kg + (size_t)((tok0) + row) * 1024 + h * 128 + ch * 8); } \
        _Pragma("unroll") for (int j_ = 0; j_ < 4; ++j_) { const int c = tid + 512 * j_, row = c >> 5, ch = c & 31; \
            sv[j_] = *(const u32x4*)(Vg + (size_t)((tok0) + row) * 2048 + h * 256 + ch * 8); } } while (0)
#define RET_WRITE() do { \
        _Pragma("unroll") for (int j_ = 0; j_ < 2; ++j_) { const int c = tid + 512 * j_, row = c >> 4, ch = c & 15; \
            if (!PRE) *(LAS u32x4*)(lds + R_QS + row * QS_STRIDE + ch * 16) = sq[j_]; \
            *(LAS u32x4*)(lds + R_KS + row * KS_STRIDE + ch * 16) = sk[j_]; } \
        _Pragma("unroll") for (int j_ = 0; j_ < 4; ++j_) { const int c = tid + 512 * j_, row = c >> 5, ch = c & 31; \
            *(LAS u32x4*)(lds + R_VS + row * VS_STRIDE + ch * 16) = sv[j_]; } } while (0)

    { const int tid = tid_in; RET_LOAD(tok_seg0); }
    for (int ci = 0; ci < 16; ++ci) {
        const int tok0 = tok_seg0 + 64 * ci;
        int tid_o = tid_in, lane_o = lane_in; asm volatile("" : "+v"(tid_o), "+v"(lane_o));
        const int tid = tid_o, lane = lane_o, r32 = lane & 31, hi = lane >> 5;
        const int trq = ((lane & 15) >> 2) + 8 * hi, trc = 16 * ((lane >> 4) & 1) + 4 * (lane & 3);
        const unsigned vaddr = ldsb + R_VS + trq * VS_STRIDE + (32 * wid + trc) * 2;
        const unsigned kaddr = ldsb + R_KS + trq * KS_STRIDE + trc * 2;
        RET_WRITE();
        __syncthreads();
        f32x16 o0, o1;
        if (!PRE) {
            if (wid < 4) {
                const int mt = wid >> 1, nt = wid & 1; f32x16 st;
#pragma unroll
                for (int r = 0; r < 16; ++r) st[r] = 0.f;
#pragma unroll
                for (int ks = 0; ks < 8; ++ks) {
                    const bf16x8 av = *(const LAS bf16x8*)(lds + R_KS + (32 * mt + r32) * KS_STRIDE + (16 * ks + 8 * hi) * 2);
                    const bf16x8 bv = *(const LAS bf16x8*)(lds + R_QS + (32 * nt + r32) * QS_STRIDE + (16 * ks + 8 * hi) * 2);
                    st = MFMA32(av, bv, st); }
                const int n = 32 * nt + r32;
#pragma unroll
                for (int gq = 0; gq < 4; ++gq) { float vv[4];
#pragma unroll
                    for (int i = 0; i < 4; ++i) { const int mm = 32 * mt + 8 * gq + 4 * hi + i; const int ex = (mm > n ? 2 * (mm - n) : 0) - 64;
                        vv[i] = st[4 * gq + i] * exp2f(l2g * (float)ex); }
                    u32x2 w; w.x = pk2(vv[0], vv[1]); w.y = pk2(vv[2], vv[3]);
                    *(LAS u32x2*)(lds + R_SS + n * SS_STRIDE + (32 * mt + 8 * gq + 4 * hi) * 2) = w; }
            }
#pragma unroll
            for (int r = 0; r < 16; ++r) { o0[r] = 0.f; o1[r] = 0.f; }
#pragma unroll
            for (int ks = 0; ks < 8; ++ks) {
                const bf16x8 av = *(const LAS bf16x8*)(lds + R_RT + (32 * wid + r32) * RT_STRIDE + (16 * ks + 8 * hi) * 2);
                const bf16x8 b0 = *(const LAS bf16x8*)(lds + R_QS + r32 * QS_STRIDE + (16 * ks + 8 * hi) * 2);
                const bf16x8 b1 = *(const LAS bf16x8*)(lds + R_QS + (32 + r32) * QS_STRIDE + (16 * ks + 8 * hi) * 2);
                o0 = MFMA32(av, b0, o0); o1 = MFMA32(av, b1, o1); }
            __syncthreads();
        }
        if (ci + 1 < 16) RET_LOAD(tok0 + 64);
        bf16x8 VF[4];
        { s16x4 l0 = trr(vaddr + 0 * 16 * VS_STRIDE), h0 = trr(vaddr + (0 * 16 + 4) * VS_STRIDE), l1 = trr(vaddr + 1 * 16 * VS_STRIDE), h1 = trr(vaddr + (1 * 16 + 4) * VS_STRIDE);
          s16x4 l2 = trr(vaddr + 2 * 16 * VS_STRIDE), h2 = trr(vaddr + (2 * 16 + 4) * VS_STRIDE), l3 = trr(vaddr + 3 * 16 * VS_STRIDE), h3 = trr(vaddr + (3 * 16 + 4) * VS_STRIDE);
          LDS_WAIT(); SBAR();
          VF[0] = RET_PK(l0, h0); VF[1] = RET_PK(l1, h1); VF[2] = RET_PK(l2, h2); VF[3] = RET_PK(l3, h3); }
        if (!PRE) {
#pragma unroll
            for (int ks = 0; ks < 4; ++ks) {
                const bf16x8 b0 = *(const LAS bf16x8*)(lds + R_SS + r32 * SS_STRIDE + (16 * ks + 8 * hi) * 2);
                const bf16x8 b1 = *(const LAS bf16x8*)(lds + R_SS + (32 + r32) * SS_STRIDE + (16 * ks + 8 * hi) * 2);
                o0 = MFMA32(VF[ks], b0, o0); o1 = MFMA32(VF[ks], b1, o1); }
        }
#pragma unroll
        for (int dt = 0; dt < 4; ++dt) {
            const unsigned ka = kaddr + 64 * dt;
            s16x4 l0 = trr(ka + 0 * 16 * KS_STRIDE), h0 = trr(ka + (0 * 16 + 4) * KS_STRIDE), l1 = trr(ka + 1 * 16 * KS_STRIDE), h1 = trr(ka + (1 * 16 + 4) * KS_STRIDE);
            s16x4 l2 = trr(ka + 2 * 16 * KS_STRIDE), h2 = trr(ka + (2 * 16 + 4) * KS_STRIDE), l3 = trr(ka + 3 * 16 * KS_STRIDE), h3 = trr(ka + (3 * 16 + 4) * KS_STRIDE);
#pragma unroll
            for (int r = 0; r < 16; ++r) R[dt][r] *= gc;
            LDS_WAIT(); SBAR();
            R[dt] = MFMA32(RET_PK(l0, h0), VF[0], R[dt]); R[dt] = MFMA32(RET_PK(l1, h1), VF[1], R[dt]);
            R[dt] = MFMA32(RET_PK(l2, h2), VF[2], R[dt]); R[dt] = MFMA32(RET_PK(l3, h3), VF[3], R[dt]);
        }
        if (!PRE) {
#pragma unroll
            for (int dt = 0; dt < 4; ++dt)
#pragma unroll
                for (int gq = 0; gq < 4; ++gq) { u32x2 w; w.x = pk2(R[dt][4 * gq], R[dt][4 * gq + 1]); w.y = pk2(R[dt][4 * gq + 2], R[dt][4 * gq + 3]);
                    *(LAS u32x2*)(lds + R_RT + (32 * wid + r32) * RT_STRIDE + (32 * dt + 8 * gq + 4 * hi) * 2) = w; }
            float a1 = 0.f, a2 = 0.f, b1 = 0.f, b2 = 0.f;
#pragma unroll
            for (int r = 0; r < 16; ++r) { a1 += o0[r]; a2 += o0[r] * o0[r]; b1 += o1[r]; b2 += o1[r] * o1[r]; }
            a1 += __shfl_xor(a1, 32); a2 += __shfl_xor(a2, 32); b1 += __shfl_xor(b1, 32); b2 += __shfl_xor(b2, 32);
            if (hi == 0) { *(LAS f32x2*)(lds + R_ST + (wid * 64 + r32) * 8) = (f32x2){a1, a2}; *(LAS f32x2*)(lds + R_ST + (wid * 64 + 32 + r32) * 8) = (f32x2){b1, b2}; }
            __syncthreads();
            u32x4 sgr[4];
#pragma unroll
            for (int j = 0; j < 4; ++j) { const int c = tid + 512 * j, n = c >> 5, e8 = (c & 31) * 8; sgr[j] = *(const u32x4*)(SGg + (size_t)(tok0 + n) * 2048 + h * 256 + e8); }
            float mu0, rs0, mu1, rs1;
            { float s1 = 0.f, s2 = 0.f, t1 = 0.f, t2 = 0.f;
#pragma unroll
              for (int w = 0; w < 8; ++w) { const f32x2 x = *(const LAS f32x2*)(lds + R_ST + (w * 64 + r32) * 8), y = *(const LAS f32x2*)(lds + R_ST + (w * 64 + 32 + r32) * 8); s1 += x.x; s2 += x.y; t1 += y.x; t2 += y.y; }
              mu0 = s1 * (1.0f / 256.0f); rs0 = 1.0f / sqrtf(fmaxf(s2 * (1.0f / 256.0f) - mu0 * mu0, 0.f) + RMS_EPS);
              mu1 = t1 * (1.0f / 256.0f); rs1 = 1.0f / sqrtf(fmaxf(t2 * (1.0f / 256.0f) - mu1 * mu1, 0.f) + RMS_EPS); }
#pragma unroll
            for (int gq = 0; gq < 4; ++gq) {
                u32x2 w0, w1;
                w0.x = pk2((o0[4 * gq] - mu0) * rs0, (o0[4 * gq + 1] - mu0) * rs0); w0.y = pk2((o0[4 * gq + 2] - mu0) * rs0, (o0[4 * gq + 3] - mu0) * rs0);
                w1.x = pk2((o1[4 * gq] - mu1) * rs1, (o1[4 * gq + 1] - mu1) * rs1); w1.y = pk2((o1[4 * gq + 2] - mu1) * rs1, (o1[4 * gq + 3] - mu1) * rs1);
                *(LAS u32x2*)(lds + R_OS + r32 * OS_STRIDE + (32 * wid + 8 * gq + 4 * hi) * 2) = w0;
                *(LAS u32x2*)(lds + R_OS + (32 + r32) * OS_STRIDE + (32 * wid + 8 * gq + 4 * hi) * 2) = w1; }
            __syncthreads();
#pragma unroll
            for (int j = 0; j < 4; ++j) { const int c = tid + 512 * j, n = c >> 5, e8 = (c & 31) * 8;
                const u32x4 ov = *(const LAS u32x4*)(lds + R_OS + n * OS_STRIDE + e8 * 2); const u32x4 gv = sgr[j]; u32x4 w;
#pragma unroll
                for (int q = 0; q < 4; ++q) w[q] = pk2(bf_lo(ov[q]) * silu_f(bf_lo(gv[q])), bf_hi(ov[q]) * silu_f(bf_hi(gv[q])));
                bf16_t* dstp = OUTg ? OUTg + (size_t)((tok0 + n) & rowmask) * 2048 : SGg + (size_t)(tok0 + n) * 2048;
                *(u32x4*)(dstp + h * 256 + e8) = w; }
        }
        __syncthreads();
    }
    if (PRE) {
        float* lp = Lbuf + ((size_t)(bh * 3 + g) * 8 + wid) * 4096 + lane_in;
#pragma unroll
        for (int dt = 0; dt < 4; ++dt)
#pragma unroll
            for (int r = 0; r < 16; ++r) lp[(dt * 16 + r) * 64] = R[dt][r];
    }
#undef RET_LOAD
#undef RET_WRITE
}
}

namespace att {
constexpr int KROW = 384, KBUF = 64 * KROW, VBUF = 16384;
constexpr int A_K = 0, A_V = 2 * KBUF, A_SCR = A_V + 2 * VBUF, A_END = A_SCR + 8 * 256;
static_assert(A_END <= LDS_BYTES, "attention LDS map");
__device__ __forceinline__ int koff(int row, int cb) { return row * KROW + (cb ^ ((row & 7) << 4)); }
__device__ __forceinline__ int v_st(int k, int c) { const int kk = (k & ~0xC) | ((k & 4) << 1) | ((k & 8) >> 1); return ((kk >> 3) * 4 + (c >> 5)) * 512 + ((kk & 7) * 32 + (c & 31)) * 2; }
__device__ __forceinline__ int v_rd_base(int lane) { return ((lane & 3) << 3) | (((lane >> 2) & 3) << 6) | (((lane >> 4) & 1) << 5) | (((lane >> 5) & 1) << 8); }
constexpr int v_rd_off(int d0, int ks, int half) { return d0 * 512 + ks * 4096 + half * 2048; }
template <int OFF> __device__ __forceinline__ s16x4 tr_read(int vb) { s16x4 r; asm volatile("ds_read_b64_tr_b16 %0, %1 offset:%2" : "=&v"(r) : "v"(vb), "i"(OFF) : "memory"); return r; }
template <int D0> __device__ __forceinline__ void pv_one(f32x16& od, int vb, bf16x8 pa0, bf16x8 pa1, bf16x8 pa2, bf16x8 pa3) {
    const s16x4 l0 = tr_read<v_rd_off(D0, 0, 0)>(vb), h0 = tr_read<v_rd_off(D0, 0, 1)>(vb), l1 = tr_read<v_rd_off(D0, 1, 0)>(vb), h1 = tr_read<v_rd_off(D0, 1, 1)>(vb);
    const s16x4 l2 = tr_read<v_rd_off(D0, 2, 0)>(vb), h2 = tr_read<v_rd_off(D0, 2, 1)>(vb), l3 = tr_read<v_rd_off(D0, 3, 0)>(vb), h3 = tr_read<v_rd_off(D0, 3, 1)>(vb);
    LDS_WAIT(); SBAR();
    __builtin_amdgcn_s_setprio(1);
    od = MFMA32(pa0, RET_PK(l0, h0), od); od = MFMA32(pa1, RET_PK(l1, h1), od); od = MFMA32(pa2, RET_PK(l2, h2), od); od = MFMA32(pa3, RET_PK(l3, h3), od);
    __builtin_amdgcn_s_setprio(0);
}

constexpr float ATT_THR = 11.5f;
__device__ __forceinline__ void partialSM(f32x16& p0, f32x16& p1, float& m_reg, float& mn, float& alpha) {
    float t8[8];
#pragma unroll
    for (int r = 0; r < 8; ++r) t8[r] = fmaxf(fmaxf(p0[r], p0[r + 8]), fmaxf(p1[r], p1[r + 8]));
    float pmax = fmaxf(fmaxf(fmaxf(t8[0], t8[1]), fmaxf(t8[2], t8[3])), fmaxf(fmaxf(t8[4], t8[5]), fmaxf(t8[6], t8[7])));
    { auto rr = __builtin_amdgcn_permlane32_swap(__float_as_uint(pmax), __float_as_uint(pmax), false, false); pmax = fmaxf(__uint_as_float(rr[0]), __uint_as_float(rr[1])); }
    if (__builtin_expect(__all(pmax - m_reg <= ATT_THR), 1)) { mn = m_reg; alpha = 1.f; }
    else { mn = fmaxf(m_reg, pmax); alpha = __builtin_amdgcn_exp2f(m_reg - mn); m_reg = mn; }
#pragma unroll
    for (int r = 0; r < 16; ++r) { p0[r] = p0[r] - mn; p1[r] = p1[r] - mn; }
#pragma unroll
    for (int r = 0; r < 16; ++r) p0[r] = __builtin_amdgcn_exp2f(p0[r]);
}
__device__ __forceinline__ void finishSM(f32x16& p0, f32x16& p1, float alpha, float& l_reg, bf16x8& pa0, bf16x8& pa1, bf16x8& pa2, bf16x8& pa3) {
#pragma unroll
    for (int r = 0; r < 16; ++r) p1[r] = __builtin_amdgcn_exp2f(p1[r]);
    float s8[8];
#pragma unroll
    for (int r = 0; r < 8; ++r) s8[r] = (p0[r] + p0[r + 8]) + (p1[r] + p1[r + 8]);
    float ps = ((s8[0] + s8[1]) + (s8[2] + s8[3])) + ((s8[4] + s8[5]) + (s8[6] + s8[7]));
    { auto rr = __builtin_amdgcn_permlane32_swap(__float_as_uint(ps), __float_as_uint(ps), false, false); ps = __uint_as_float(rr[0]) + __uint_as_float(rr[1]); }
    l_reg = l_reg * alpha + ps;
#define PK4(P, BASE, OUT) do { unsigned a0 = pk2(P[BASE + 0], P[BASE + 1]), a1 = pk2(P[BASE + 2], P[BASE + 3]);   \
    unsigned b0 = pk2(P[BASE + 4], P[BASE + 5]), b1 = pk2(P[BASE + 6], P[BASE + 7]);                              \
    auto r0 = __builtin_amdgcn_permlane32_swap(a0, b0, false, false); auto r1 = __builtin_amdgcn_permlane32_swap(a1, b1, false, false); \
    u32x4 w = {r0[0], r1[0], r0[1], r1[1]}; OUT = *reinterpret_cast<bf16x8*>(&w); } while (0)
    PK4(p0, 0, pa0); PK4(p0, 8, pa1); PK4(p1, 0, pa2); PK4(p1, 8, pa3);
#undef PK4
}
__device__ __forceinline__ void pv_all(f32x16 (&o)[4], int vb, bf16x8 pa0, bf16x8 pa1, bf16x8 pa2, bf16x8 pa3) {
    pv_one<0>(o[0], vb, pa0, pa1, pa2, pa3); pv_one<1>(o[1], vb, pa0, pa1, pa2, pa3); pv_one<2>(o[2], vb, pa0, pa1, pa2, pa3); pv_one<3>(o[3], vb, pa0, pa1, pa2, pa3);
}
constexpr int B_KN = 0, B_KR = 3 * 16384, B_V = B_KR + 3 * 8192, B_SCR = B_V + 3 * 16384, B_STG = B_SCR + 8 * 256, B_END = B_STG + 8 * 4608;
static_assert(B_END <= LDS_BYTES - 64, "attention v3 LDS map");
__device__ __forceinline__ void qkt3(f32x16& p0, f32x16& p1, const LAS unsigned char* Knb, const LAS unsigned char* Krb, const bf16x8 (&qr)[12], int r32, int hi, bool masked) {
#pragma unroll
    for (int r = 0; r < 16; ++r) { p0[r] = 0.f; p1[r] = 0.f; }
    const int x0 = (r32 & 15) << 4, rr0 = r32 * 256, rr1 = (32 + r32) * 256;
    __builtin_amdgcn_s_setprio(1);
#pragma unroll
    for (int d0 = 0; d0 < 8; ++d0) { const int cb = (d0 * 32 + hi * 16) ^ x0;
        const bf16x8 k0 = *(const LAS bf16x8*)(Knb + rr0 + cb), k1 = *(const LAS bf16x8*)(Knb + rr1 + cb);
        p0 = MFMA32(k0, qr[d0], p0); p1 = MFMA32(k1, qr[d0], p1); }
    const int y0 = ((r32 >> 1) & 7) << 4, qq0 = r32 * 128, qq1 = (32 + r32) * 128;
#pragma unroll
    for (int d0 = 0; d0 < 4; ++d0) { const int cb = (d0 * 32 + hi * 16) ^ y0;
        const bf16x8 k0 = *(const LAS bf16x8*)(Krb + qq0 + cb), k1 = *(const LAS bf16x8*)(Krb + qq1 + cb);
        p0 = MFMA32(k0, qr[8 + d0], p0); p1 = MFMA32(k1, qr[8 + d0], p1); }
    __builtin_amdgcn_s_setprio(0);
    if (masked) {
#pragma unroll
        for (int r = 0; r < 16; ++r) { p0[r] = -1e30f; p1[r] = -1e30f; } }
}
__device__ __forceinline__ void attn_unit3(LAS unsigned char* lds, const bf16_t* __restrict__ Q, const float* __restrict__ PQ, const f32x4* __restrict__ TB, const bf16_t* __restrict__ Kn, const bf16_t* __restrict__ Kr, const bf16_t* __restrict__ V2, bf16_t* SGA,
                                           int b, int h, int qb, int wid, int lane, bf16_t* OUTP, int rowmask) {
    const int r32 = lane & 31, hi = lane >> 5;
    const int R0 = b * SEQ + qb * 256, kb0 = b * SEQ, NT = 4 * qb + 4, jmax = 4 * qb + (wid >> 1);
    bf16x8 qr[12];
    { const int qrow = R0 + 32 * wid + r32; const bf16_t* qp = Q + (size_t)qrow * QROW + h * 192 + hi * 8;
      u32x4 qw[12];
#pragma unroll
      for (int d0 = 0; d0 < 12; ++d0) qw[d0] = *(const u32x4*)(qp + d0 * 16);
      const f32x4* pp = (const f32x4*)(PQ + (size_t)qrow * 12); const f32x4 s0 = pp[0], s1 = pp[1], s2 = pp[2];
      const float ss = ((s0[0] + s0[1]) + (s0[2] + s0[3])) + ((s1[0] + s1[1]) + (s1[2] + s1[3])) + ((s2[0] + s2[1]) + (s2[2] + s2[3]));
      const float rs = (1.0f / sqrtf(ss * (1.0f / 384.0f) + RMS_EPS)) * (0.07216878364870322f * 1.4426950408889634f);
#pragma unroll
      for (int d0 = 0; d0 < 8; ++d0) { u32x4 w;
#pragma unroll
          for (int q = 0; q < 4; ++q) w[q] = pk2(bf_lo(qw[d0][q]) * rs, bf_hi(qw[d0][q]) * rs);
          qr[d0] = *reinterpret_cast<bf16x8*>(&w); }
      const int pos = qrow & 4095;
#pragma unroll
      for (int i = 0; i < 2; ++i) {
          const f32x4* tp = TB + ((size_t)pos * 32 + 16 * i + 8 * hi) / 2; u32x4 w1, w2;
#pragma unroll
          for (int q = 0; q < 4; ++q) { const f32x4 t = tp[q];
              const float x1a = bf_lo(qw[8 + i][q]) * rs, x1b = bf_hi(qw[8 + i][q]) * rs, x2a = bf_lo(qw[10 + i][q]) * rs, x2b = bf_hi(qw[10 + i][q]) * rs;
              w1[q] = pk2(x1a * t[0] - x2a * t[1], x1b * t[2] - x2b * t[3]); w2[q] = pk2(x1a * t[1] + x2a * t[0], x1b * t[3] + x2b * t[2]); }
          qr[8 + i] = *reinterpret_cast<bf16x8*>(&w1); qr[10 + i] = *reinterpret_cast<bf16x8*>(&w2); }
    }
    asm volatile("s_waitcnt vmcnt(0)" ::: "memory");
    LAS float* al_l = (LAS float*)(lds + B_SCR + wid * 256); LAS float* li_l = al_l + 32;
    const int vb0 = (int)(unsigned)(size_t)(lds + B_V) + v_rd_base(lane);
    float m_reg = -1e30f, l_reg = 0.f; f32x16 o[4];
#pragma unroll
    for (int d = 0; d < 4; ++d)
#pragma unroll
        for (int r = 0; r < 16; ++r) o[d][r] = 0.f;
    unsigned okn[2], okr, ov[2];
#pragma unroll
    for (int i = 0; i < 2; ++i) {
        { const int row = (wid * 2 + i) * 4 + (lane >> 4), c = (lane & 15) ^ (row & 15); okn[i] = (unsigned)(row * 1024 + c * 8) * 2u; }
        { const int s = (wid * 2 + i) * 64 + lane, sub = s >> 5, t = s & 31, kk = (sub >> 2) * 8 + (t >> 2), k = (kk & ~0xC) | ((kk & 4) << 1) | ((kk & 8) >> 1), c = (sub & 3) * 32 + (t & 3) * 8;
          ov[i] = (unsigned)(k * 1024 + c) * 2u; }
    }
    { const int row = wid * 8 + (lane >> 3), c = (lane & 7) ^ ((row >> 1) & 7); okr = (unsigned)(row * 64 + c * 8) * 2u; }
    const char* KnT = (const char*)(Kn + (size_t)kb0 * 1024 + h * 128); const char* KrT = (const char*)(Kr + (size_t)kb0 * 64); const char* VT = (const char*)(V2 + (size_t)kb0 * 1024 + h * 128);
#define ATT_DMA(tile, buf) do { \
        const char* kn_ = KnT + (size_t)(tile) * (64 * 1024 * 2); const char* kr_ = KrT + (size_t)(tile) * (64 * 64 * 2); const char* v_ = VT + (size_t)(tile) * (64 * 1024 * 2); \
        __builtin_amdgcn_global_load_lds((const unsigned*)(kn_ + okn[0]), (LAS unsigned*)(lds + B_KN + (buf) * 16384 + (wid * 2 + 0) * 1024), 16, 0, 0); \
        __builtin_amdgcn_global_load_lds((const unsigned*)(kn_ + okn[1]), (LAS unsigned*)(lds + B_KN + (buf) * 16384 + (wid * 2 + 1) * 1024), 16, 0, 0); \
        __builtin_amdgcn_global_load_lds((const unsigned*)(kr_ + okr),    (LAS unsigned*)(lds + B_KR + (buf) * 8192 + wid * 1024), 16, 0, 0); \
        __builtin_amdgcn_global_load_lds((const unsigned*)(v_ + ov[0]),   (LAS unsigned*)(lds + B_V + (buf) * 16384 + (wid * 2 + 0) * 1024), 16, 0, 0); \
        __builtin_amdgcn_global_load_lds((const unsigned*)(v_ + ov[1]),   (LAS unsigned*)(lds + B_V + (buf) * 16384 + (wid * 2 + 1) * 1024), 16, 0, 0); } while (0)
#define RESC(a) do { if (__any((a) < 1.f)) { if (HI == 0) al_l[R32] = (a); LDS_WAIT(); \
        _Pragma("unroll") for (int r = 0; r < 16; ++r) { const float av = al_l[crow(r, HI)]; _Pragma("unroll") for (int d = 0; d < 4; ++d) o[d][r] *= av; } } } while (0)
    f32x16 pA0, pA1, pB0, pB1; float mnA, mnB, alA, alB; bf16x8 pa0, pa1, pa2, pa3;
    int lane_v = lane;
#define OPQ() asm volatile("" : "+v"(lane_v), "+v"(okn[0]), "+v"(okn[1]), "+v"(okr), "+v"(ov[0]), "+v"(ov[1]))
#define R32 (lane_v & 31)
#define HI (lane_v >> 5)
#define DMA_K(tile, buf) do { const char* kn_ = KnT + (size_t)(tile) * (64 * 1024 * 2); const char* kr_ = KrT + (size_t)(tile) * (64 * 64 * 2); \
        __builtin_amdgcn_global_load_lds((const unsigned*)(kn_ + okn[0]), (LAS unsigned*)(lds + B_KN + (buf) * 16384 + (wid * 2 + 0) * 1024), 16, 0, 0); \
        __builtin_amdgcn_global_load_lds((const unsigned*)(kn_ + okn[1]), (LAS unsigned*)(lds + B_KN + (buf) * 16384 + (wid * 2 + 1) * 1024), 16, 0, 0); \
        __builtin_amdgcn_global_load_lds((const unsigned*)(kr_ + okr),    (LAS unsigned*)(lds + B_KR + (buf) * 8192 + wid * 1024), 16, 0, 0); } while (0)
#define DMA_V(tile, buf) do { const char* v_ = VT + (size_t)(tile) * (64 * 1024 * 2); \
        __builtin_amdgcn_global_load_lds((const unsigned*)(v_ + ov[0]),   (LAS unsigned*)(lds + B_V + (buf) * 16384 + (wid * 2 + 0) * 1024), 16, 0, 0); \
        __builtin_amdgcn_global_load_lds((const unsigned*)(v_ + ov[1]),   (LAS unsigned*)(lds + B_V + (buf) * 16384 + (wid * 2 + 1) * 1024), 16, 0, 0); } while (0)
#define BAR_V(n) do { asm volatile("s_waitcnt vmcnt(" #n ") lgkmcnt(0)" ::: "memory"); __builtin_amdgcn_s_barrier(); asm volatile("" ::: "memory"); } while (0)
    DMA_K(0, 0); DMA_V(0, 0); DMA_K(1, 1);
    DMA_V(1, 1); DMA_K(2, 2);
    BAR_V(5);
    qkt3(pA0, pA1, lds + B_KN, lds + B_KR, qr, R32, HI, false); partialSM(pA0, pA1, m_reg, mnA, alA);
    BAR_V(5);
    int bp = 0, bc = 1, bn = 2;
    for (int j = 1; j + 1 < NT; j += 2) {
        OPQ(); SBAR(); DMA_V(j + 1, bn); DMA_K(j + 2, bp); SBAR();
        qkt3(pB0, pB1, lds + B_KN + bc * 16384, lds + B_KR + bc * 8192, qr, R32, HI, j > jmax);
        finishSM(pA0, pA1, alA, l_reg, pa0, pa1, pa2, pa3); SBAR();
        pv_all(o, vb0 + bp * 16384, pa0, pa1, pa2, pa3); partialSM(pB0, pB1, m_reg, mnB, alB);
        BAR_V(5); RESC(alB);
        { const int t_ = bp; bp = bc; bc = bn; bn = t_; }
        const bool more = (j + 3 < NT);
        OPQ(); SBAR(); DMA_V(j + 2, bn); if (more) DMA_K(j + 3, bp); SBAR();
        qkt3(pA0, pA1, lds + B_KN + bc * 16384, lds + B_KR + bc * 8192, qr, R32, HI, j + 1 > jmax);
        finishSM(pB0, pB1, alB, l_reg, pa0, pa1, pa2, pa3); SBAR();
        pv_all(o, vb0 + bp * 16384, pa0, pa1, pa2, pa3); partialSM(pA0, pA1, m_reg, mnA, alA);
        if (more) BAR_V(5); else BAR_V(2);
        RESC(alA);
        { const int t_ = bp; bp = bc; bc = bn; bn = t_; }
    }
    OPQ(); SBAR(); qkt3(pB0, pB1, lds + B_KN + bc * 16384, lds + B_KR + bc * 8192, qr, R32, HI, NT - 1 > jmax);
    finishSM(pA0, pA1, alA, l_reg, pa0, pa1, pa2, pa3); SBAR();
    pv_all(o, vb0 + bp * 16384, pa0, pa1, pa2, pa3); partialSM(pB0, pB1, m_reg, mnB, alB);
    BAR_V(0); RESC(alB);
    finishSM(pB0, pB1, alB, l_reg, pa0, pa1, pa2, pa3); SBAR();
    pv_all(o, vb0 + bc * 16384, pa0, pa1, pa2, pa3);
    if (hi == 0) li_l[r32] = l_reg;
    LDS_WAIT();
    float rl[16];
#pragma unroll
    for (int r = 0; r < 16; ++r) rl[r] = __builtin_amdgcn_rcpf(li_l[crow(r, hi)]);
    LAS unsigned char* stg = lds + B_STG + wid * 4608;
#pragma unroll
    for (int half = 0; half < 2; ++half) {
        u32x4 gv[4];
#pragma unroll
        for (int i = 0; i < 4; ++i) gv[i] = *(const u32x4*)(SGA + (size_t)(R0 + 32 * wid + (lane >> 3) + 8 * i) * 1024 + h * 128 + 64 * half + (lane & 7) * 8);
#pragma unroll
        for (int dd = 0; dd < 2; ++dd)
#pragma unroll
            for (int r = 0; r < 16; ++r) *(LAS bf16_t*)(stg + crow(r, hi) * 144 + (32 * dd + r32) * 2) = (bf16_t)(pk2(o[2 * half + dd][r] * rl[r], 0.f) & 0xffffu);
        LDS_WAIT();
#pragma unroll
        for (int i = 0; i < 4; ++i) { const u32x4 ov = *(const LAS u32x4*)(stg + ((lane >> 3) + 8 * i) * 144 + (lane & 7) * 16); u32x4 w;
#pragma unroll
            for (int q = 0; q < 4; ++q) w[q] = pk2(bf_lo(ov[q]) * silu_f(bf_lo(gv[i][q])), bf_hi(ov[q]) * silu_f(bf_hi(gv[i][q])));
            bf16_t* dstp = OUTP ? OUTP + (size_t)((R0 + 32 * wid + (lane >> 3) + 8 * i) & rowmask) * 1024 : SGA + (size_t)(R0 + 32 * wid + (lane >> 3) + 8 * i) * 1024;
            *(u32x4*)(dstp + h * 128 + 64 * half + (lane & 7) * 8) = w; }
        LDS_WAIT();
    }
    __syncthreads();
#undef ATT_DMA
#undef DMA_K
#undef DMA_V
#undef BAR_V
#undef RESC
#undef OPQ
#undef R32
#undef HI
}
}


#ifdef DBG_NAIVE_ATT
__device__ __forceinline__ void attn_naive_unit(LAS unsigned char* lds, const bf16_t* Q, const float* PQ, const f32x2* TB, const bf16_t* Kn, const bf16_t* Kr, const bf16_t* V2, bf16_t* SGA, int b, int h, int c, int tid) {
    LAS float* Qs = (LAS float*)lds;
    const int row = tid >> 3, part = tid & 7, tok = b * SEQ + c * 64 + row, pos = tok & 4095;
    float ss = 0.f; for (int i = 0; i < 12; ++i) ss += PQ[(size_t)tok * 12 + i];
    const float rs = (1.0f / sqrtf(ss * (1.0f / 384.0f) + RMS_EPS)) * 0.07216878364870322f;
    for (int i = 0; i < 16; ++i) { const int d = part + 8 * i; Qs[row * 193 + d] = bf1(Q[(size_t)tok * QROW + h * 192 + d]) * rs; }
    for (int i = 0; i < 4; ++i) { const int dd = part + 8 * i; const f32x2 cs = TB[pos * 32 + dd];
        const float x1 = bf1(Q[(size_t)tok * QROW + h * 192 + 128 + dd]) * rs, x2 = bf1(Q[(size_t)tok * QROW + h * 192 + 160 + dd]) * rs;
        Qs[row * 193 + 128 + dd] = x1 * cs.x - x2 * cs.y; Qs[row * 193 + 160 + dd] = x1 * cs.y + x2 * cs.x; }
    __syncthreads();
    float m = -1e30f, l = 0.f, acc[16];
    for (int i = 0; i < 16; ++i) acc[i] = 0.f;
    const int nk = 64 * (c + 1);
    for (int key = 0; key < nk; ++key) {
        const size_t kt = (size_t)(b * SEQ + key);
        float s = 0.f;
        for (int d = 0; d < 128; ++d) s += Qs[row * 193 + d] * bf1(Kn[kt * 1024 + h * 128 + d]);
        for (int d = 0; d < 64; ++d) s += Qs[row * 193 + 128 + d] * bf1(Kr[kt * 64 + d]);
        const float mn = fmaxf(m, s), al = __expf(m - mn), pe = __expf(s - mn); m = mn; l = l * al + pe;
        for (int i = 0; i < 16; ++i) acc[i] = acc[i] * al + pe * bf1(V2[kt * 1024 + h * 128 + part * 16 + i]);
    }
    for (int i = 0; i < 16; ++i) { bf16_t* op = SGA + (size_t)tok * 1024 + h * 128 + part * 16 + i; *op = (bf16_t)(pk2(acc[i] / l * silu_f(bf1(*op)), 0.f) & 0xffffu); }
    __syncthreads();
}
#endif
#define XB_TMO      128
#define XB_XCNT(j)  (256  + 64 * (j))
#define XB_XSUB(j)  (1280 + 64 * (j))
#define XB_XGEN(j)  (2304 + 64 * (j))
#define XB_TOP      3328
#define XB_TOPGEN   3392
#define XCD_BAR_WORDS 3456
#define XB_SPIN_CAP (1u << 24)

__device__ __forceinline__ unsigned xb_ld(unsigned* p)              { return __hip_atomic_load(p, __ATOMIC_RELAXED, __HIP_MEMORY_SCOPE_AGENT); }
__device__ __forceinline__ unsigned xb_add(unsigned* p, unsigned v) { return __hip_atomic_fetch_add(p, v, __ATOMIC_RELAXED, __HIP_MEMORY_SCOPE_AGENT); }
__device__ __forceinline__ unsigned xb_xcc_id() { return (unsigned)__builtin_amdgcn_s_getreg((3 << 11) | 20) & 0xFu; }
#define XB_SPIN(cond, bar) do { unsigned _sp = 0; while (cond) { __builtin_amdgcn_s_sleep(1); \
    if ((++_sp & 255u) == 0u) { if (xb_ld(&(bar)[XB_TMO])) break; if (_sp > XB_SPIN_CAP) { atomicAdd(&(bar)[XB_TMO], 1u); break; } } } } while (0)

struct XcdBarrier {
    unsigned* bar; unsigned x;
    volatile LAS unsigned* st;
};

__device__ __forceinline__ XcdBarrier xcd_barrier_post(unsigned* bar, volatile LAS unsigned* st, int tid) {
    XcdBarrier b; b.bar = bar; b.x = xb_xcc_id(); b.st = st;
    if (tid == 0) (void)xb_add(&bar[XB_XCNT(b.x)], 1u);
    return b;
}
__device__ __forceinline__ void xcd_barrier_complete(unsigned* bar, unsigned x, unsigned& nloc, unsigned& nx) {
    const unsigned G = gridDim.x * gridDim.y * gridDim.z;
    unsigned sum, cnt, mine, sp = 0u;
    for (;;) {
        sum = 0u; cnt = 0u; mine = 0u;
#pragma unroll
        for (unsigned j = 0; j < 16; ++j) { const unsigned c = xb_ld(&bar[XB_XCNT(j)]); sum += c; cnt += (c > 0u) ? 1u : 0u; mine = (j == x) ? c : mine; }
        if (sum == G) break;
        __builtin_amdgcn_s_sleep(1);
        if ((++sp & 255u) == 0u) { if (xb_ld(&bar[XB_TMO])) break; if (sp > XB_SPIN_CAP) { atomicAdd(&bar[XB_TMO], 1u); break; } }
    }
    nloc = mine > 0u ? mine : 1u; nx = cnt > 0u ? cnt : 1u;
}

__device__ __forceinline__ void xcd_barrier(const XcdBarrier& b, int tid) {
    asm volatile("s_waitcnt vmcnt(0)" ::: "memory");
    __syncthreads();
    if (tid == 0) {
        unsigned* bar = b.bar;
        __builtin_amdgcn_s_waitcnt(0);
        unsigned nloc = b.st[0], nx = b.st[1];
        if (nloc == 0u) { xcd_barrier_complete(bar, b.x, nloc, nx); b.st[0] = nloc; b.st[1] = nx; }
        const unsigned old = xb_add(&bar[XB_XSUB(b.x)], 1u);
        const unsigned gen = old / nloc;
        if (old + 1u == (gen + 1u) * nloc) {
            __builtin_amdgcn_fence(__ATOMIC_RELEASE, "agent");
            asm volatile("s_waitcnt vmcnt(0)" ::: "memory");
            const unsigned og = xb_add(&bar[XB_TOP], 1u);
            const unsigned tg = og / nx;
            if (og + 1u == (tg + 1u) * nx) xb_add(&bar[XB_TOPGEN], 1u);
            else XB_SPIN(xb_ld(&bar[XB_TOPGEN]) == tg, bar);
            __builtin_amdgcn_fence(__ATOMIC_ACQUIRE, "agent");
            xb_add(&bar[XB_XGEN(b.x)], 1u);
            asm volatile("s_waitcnt vmcnt(0)" ::: "memory");
        } else {
            XB_SPIN(xb_ld(&bar[XB_XGEN(b.x)]) == gen, bar);
            __builtin_amdgcn_fence(__ATOMIC_ACQUIRE, "agent");
            asm volatile("s_waitcnt vmcnt(0)" ::: "memory");
        }
    }
    __syncthreads();
}
__global__ void __launch_bounds__(NTHREADS, 2) yoco_fwd(Args args) {
    extern __shared__ __attribute__((aligned(16))) unsigned char lds_raw[];
    LAS unsigned char* lds = (LAS unsigned char*)lds_raw;
    cg::grid_group grid = cg::this_grid();
    const int wave = __builtin_amdgcn_readfirstlane(threadIdx.x >> 6);
#define PHASE_IDS() int lane_p; asm volatile("v_mbcnt_lo_u32_b32 %0, -1, 0\n\tv_mbcnt_hi_u32_b32 %0, -1, %0" : "=v"(lane_p)); const int lane = lane_p, tid = wave * 64 + lane; (void)tid; (void)lane
    const int G = gridDim.x, bx = blockIdx.x;
    const int vcu = (G % 8 == 0) ? (bx % 8) * (G / 8) + bx / 8 : bx;
    const int gw = vcu * NWAVES + wave, NGW = G * NWAVES;
    unsigned char* ws = args.ws;
    volatile LAS unsigned* MISC = (volatile LAS unsigned*)(lds + LDS_BYTES - 64);
    XcdBarrier bar;
    { PHASE_IDS(); if (tid < 16) MISC[tid] = 0u; __syncthreads(); bar = xcd_barrier_post((unsigned*)(ws + WS_CTL), MISC, tid); }
    const int lo = args.ph_lo, hi_ph = args.ph_hi;
#ifndef PH_MASK
#define PH_MASK 0x7ff
#endif
#ifndef DUP_PHASE
#define DUP_PHASE (-1)
#endif
#define IN(k) ((((PH_MASK) >> (k)) & 1) && lo <= (k) && (k) < hi_ph)
#define SEAM(k) do { if (IN(k) && IN((k) + 1)) { if ((k) == 0) grid.sync(); else { PHASE_IDS(); xcd_barrier(bar, tid); } } } while (0)
#define PHASE(k) if (IN(k)) for (int rep = 0; rep < ((DUP_PHASE) == (k) ? 2 : 1); ++rep)
#define DUPBAR() if (rep) xcd_barrier(bar, tid)
#define FIRST_OF_DUP(k) ((DUP_PHASE) == (k) && rep == 0)
    bf16_t* XN = (bf16_t*)(ws + WS_XN); bf16_t* Qb = (bf16_t*)(ws + WS_Q); bf16_t* Kb = (bf16_t*)(ws + WS_K); bf16_t* Vb = (bf16_t*)(ws + WS_V); bf16_t* SG = (bf16_t*)(ws + WS_G);
    float* Lb = (float*)(ws + WS_L);

    PHASE(0) { PHASE_IDS(); DUPBAR(); p0_prologue(args, lds, gw, NGW, wave, lane); }
    SEAM(0);
    PHASE(1) {
        PHASE_IDS(); DUPBAR();
        pg8::Gemm g{XN, (const bf16_t*)(ws + WS_W1), MTOK, N1, DM}; pg8::StaticOrder S; S.init(MTOK, N1, G, bx);
        EpiP1 E{Qb, Kb, Vb, SG, (const f32x4*)(ws + WS_TABA)};
        pg8::gemm_phase<EpiP1, pg8::StaticOrder, true, true>(lds, g, S, E, tid);
    }
    SEAM(1);
    PHASE(2) { PHASE_IDS(); DUPBAR(); for (int it = bx; it < 192; it += G) ret::ret_item<true>(lds, Qb, Kb, Vb, SG, Lb, it / 3, it % 3, tid, wave, lane, nullptr, -1); }
    SEAM(2);
    PHASE(3) { PHASE_IDS(); DUPBAR(); for (int it = bx; it < 256; it += G) ret::ret_item<false>(lds, Qb, Kb, Vb, SG, Lb, it >> 2, it & 3, tid, wave, lane, FIRST_OF_DUP(3) ? XN : nullptr, 16383); }
    SEAM(3);
    PHASE(4) {
        PHASE_IDS(); DUPBAR();
        pg8::Gemm g{SG, (const bf16_t*)(ws + WS_W2), MTOK, DM, 2048}; pg8::StaticOrder S; S.init(MTOK, DM, G, bx);
        EpiPlain E{(bf16_t*)(ws + WS_Y1), DM};
        pg8::gemm_phase<EpiPlain, pg8::StaticOrder, true, true>(lds, g, S, E, tid);
    }
    SEAM(4);
    PHASE(5) { PHASE_IDS(); DUPBAR(); row_phase<false, true, true>((const bf16_t*)(ws + WS_Y1), args.in[0], args.in[5], (bf16_t*)(ws + WS_H1), (bf16_t*)(ws + WS_XN2), gw, NGW, lane); }
    SEAM(5);
    PHASE(6) {
        PHASE_IDS(); DUPBAR();
        pg8::Gemm g{(const bf16_t*)(ws + WS_XN2), (const bf16_t*)(ws + WS_W3), MTOK, N3, DM}; pg8::StaticOrder S; S.init(MTOK, N3, G, bx);
        EpiP4 E{(bf16_t*)(ws + WS_SG2), (bf16_t*)(ws + WS_CQ), (bf16_t*)(ws + WS_CKV), (float*)(ws + WS_KRR), (float*)(ws + WS_PQ), (float*)(ws + WS_PKV)};
        pg8::gemm_phase<EpiP4, pg8::StaticOrder, true, true>(lds, g, S, E, tid);
    }
    SEAM(6);
    PHASE(7) {
        PHASE_IDS(); DUPBAR();
        { const float* krr = (const float*)(ws + WS_KRR); bf16_t* kr = (bf16_t*)(ws + WS_KR); const f32x2* tB = (const f32x2*)(ws + WS_TABB);
          for (int i = gw * 64 + lane; i < MTOK * 32; i += NGW * 64) { const int row = i >> 5, dd = i & 31, pos = row & 4095; const f32x2 cs = tB[pos * 32 + dd];
              const float x1 = krr[(size_t)row * 64 + dd], x2 = krr[(size_t)row * 64 + 32 + dd];
              kr[(size_t)row * 64 + dd] = (bf16_t)(pk2(x1 * cs.x - x2 * cs.y, 0.f) & 0xffffu); kr[(size_t)row * 64 + 32 + dd] = (bf16_t)(pk2(x1 * cs.y + x2 * cs.x, 0.f) & 0xffffu); } }
        { pg8::Gemm g{(const bf16_t*)(ws + WS_CQ), (const bf16_t*)(ws + WS_WUQ), MTOK, QROW, 384}; pg8::StaticOrder S; S.init(MTOK, QROW, G, bx);
          EpiPlain E{(bf16_t*)(ws + WS_QM), QROW};
          pg8::gemm_phase<EpiPlain, pg8::StaticOrder, true, true>(lds, g, S, E, tid); }
        { pg8::Gemm g{(const bf16_t*)(ws + WS_CKV), (const bf16_t*)(ws + WS_WKV), MTOK, 2048, 256}; pg8::StaticOrder S; S.init(MTOK, 2048, G, bx);
          EpiP5kv E{(bf16_t*)(ws + WS_KN), (bf16_t*)(ws + WS_V2), (const float*)(ws + WS_PKV)};
          pg8::gemm_phase<EpiP5kv, pg8::StaticOrder, true, true>(lds, g, S, E, tid); }
    }
    SEAM(7);
    PHASE(8) {
        PHASE_IDS(); DUPBAR();
        const bf16_t* Qm = (const bf16_t*)(ws + WS_QM); const bf16_t* Kn = (const bf16_t*)(ws + WS_KN); const bf16_t* Kr = (const bf16_t*)(ws + WS_KR); const bf16_t* V2 = (const bf16_t*)(ws + WS_V2);
        bf16_t* SGA = (bf16_t*)(ws + WS_SG2);
#ifdef DBG_NAIVE_ATT
        for (int u = bx; u < 4096; u += G) attn_naive_unit(lds, Qm, (const float*)(ws + WS_PQ), (const f32x2*)(ws + WS_TABB), Kn, Kr, V2, SGA, u >> 9, (u >> 6) & 7, ((u & 63) + 5 * (u >> 8)) & 63, tid);
#else
        for (int i = 0;; ++i) {
            const int L = i * G + vcu; if (L >= 1024) break;
            int bhq, qb;
            if (G == 256) { const int j = vcu & 3; bhq = vcu >> 2; qb = (i == 0) ? 15 - j : (i == 1) ? 8 + j : (i == 2) ? 7 - j : j; }
            else { bhq = L >> 4; qb = 15 - (L & 15); }
            att::attn_unit3(lds, Qm, (const float*)(ws + WS_PQ), (const f32x4*)(ws + WS_TABB), Kn, Kr, V2, SGA, bhq >> 3, bhq & 7, qb, wave, lane, FIRST_OF_DUP(8) ? (bf16_t*)(ws + WS_CQ) : nullptr, 16383);
        }
#endif
    }
    SEAM(8);
    PHASE(9) {
        PHASE_IDS(); DUPBAR();
        pg8::Gemm g{(const bf16_t*)(ws + WS_SG2), (const bf16_t*)(ws + WS_W5), MTOK, DM, DM}; pg8::StaticOrder S; S.init(MTOK, DM, G, bx);
        EpiPlain E{(bf16_t*)(ws + WS_Y2), DM};
        pg8::gemm_phase<EpiPlain, pg8::StaticOrder, true, true>(lds, g, S, E, tid);
    }
    SEAM(9);
    PHASE(10) { PHASE_IDS(); DUPBAR(); row_phase<true, false, false>((const bf16_t*)(ws + WS_Y2), (const bf16_t*)(ws + WS_H1), args.in[16], args.out, nullptr, gw, NGW, lane); }
#undef IN
#undef SEAM
}

extern "C" void kernel_launch(void* const* d_in, const int* in_sizes, int n_in, void* d_out, int out_size, void* d_ws, size_t ws_size, hipStream_t stream) {
    static int grid = 0;
    if (!grid) {
        int dev = 0, cus = 0, per_cu = 0;
        if (n_in != 17 || out_size != MTOK * DM || ws_size < WS_NEED) { fprintf(stderr, "kernel_launch: unexpected shapes: n_in %d out %d ws %zu\n", n_in, out_size, ws_size); return; }
        (void)hipGetDevice(&dev);
        (void)hipDeviceGetAttribute(&cus, hipDeviceAttributeMultiprocessorCount, dev);
        (void)hipFuncSetAttribute((const void*)yoco_fwd, hipFuncAttributeMaxDynamicSharedMemorySize, LDS_BYTES);
        (void)hipOccupancyMaxActiveBlocksPerMultiprocessor(&per_cu, (const void*)yoco_fwd, NTHREADS, LDS_BYTES);
        if (per_cu < 1) { fprintf(stderr, "kernel_launch: occupancy query says %d blocks per CU\n", per_cu); }
        grid = cus > 0 ? cus : 256;
    }
    Args a{};
    for (int i = 0; i < 17; ++i) a.in[i] = (const float*)d_in[i];
    a.out = (float*)d_out; a.ws = (unsigned char*)d_ws; a.ph_lo = 0; a.ph_hi = 11;
    if (hipMemsetAsync((char*)d_ws + WS_CTL, 0, 65536, stream) != hipSuccess) { fprintf(stderr, "kernel_launch: memset failed\n"); return; }
    void* params[] = {&a};
    hipError_t e = hipLaunchCooperativeKernel((const void*)yoco_fwd, dim3(grid), dim3(NTHREADS), params, LDS_BYTES, stream);
    if (e != hipSuccess) fprintf(stderr, "kernel_launch: cooperative launch failed: %s (grid %d)\n", hipGetErrorString(e), grid);
}
```

```cpp
#include <hip/hip_runtime.h>
#include <hip/hip_cooperative_groups.h>
#include <cstdio>
#include <cstdint>
namespace cg = cooperative_groups;
namespace pg8 {
#define PG8_LAS __attribute__((address_space(3)))
typedef unsigned short bf16_t;
typedef short bf16x8 __attribute__((ext_vector_type(8)));
typedef float f32x4 __attribute__((ext_vector_type(4)));
typedef unsigned u32x4 __attribute__((ext_vector_type(4)));
constexpr int BM = 256, BK = 64, HALF = 128, HTB = HALF * BK * 2  , STAGE_BYTES = 8 * HTB, NXCD = 8, WGM = 8;

__host__ __device__ __forceinline__ int lds_byte(int r, int c) { const int st = (r >> 4) * 2 + (c >> 5), rr = r & 15, cc = c & 31, ob = rr * 64 + cc * 2; return st * 1024 + (ob ^ (((ob >> 9) & 1) << 5)); }
__host__ __device__ __forceinline__ void stage_rc(int b, int& R, int& C) { const int st = b / 1024, sb = b % 1024, swz = sb ^ (((sb >> 9) & 1) << 5); R = (st >> 1) * 16 + swz / 64; C = (st & 1) * 32 + (swz % 64) / 2; }
__host__ __device__ __forceinline__ int perm32(int rho) { const int n = rho >> 4, i = rho & 15; return 8 * (i >> 2) + 4 * n + (i & 3); }

struct Unit { int pm, pn; };
struct Gemm { const bf16_t* A; const bf16_t* Bt; int M, N, K; };

struct StaticOrder {
    int nM, nN, nwg, G, c;
    __host__ __device__ void init(int M, int N, int G_, int c_) { nM = M / BM; nN = N / BM; nwg = nM * nN; G = G_; c = c_; }
    __host__ __device__ bool next(int i, Unit& u) const {
        const long L = (long)i * G + c; if (L >= nwg) return false;
        int wgid = (int)L; { const int q = nwg / NXCD, r = nwg % NXCD, xcd = wgid % NXCD, off = wgid / NXCD; wgid = (xcd < r ? xcd * (q + 1) : r * (q + 1) + (xcd - r) * q) + off; }
        const int nig = WGM * nN, gid = wgid / nig, fm = gid * WGM, gsz = (nM - fm) < WGM ? (nM - fm) : WGM;
        u.pm = fm + ((wgid % nig) % gsz); u.pn = (wgid % nig) / gsz; return true;
    }
    __device__ __forceinline__ void a_ready(const Unit&) const {}
    __device__ __forceinline__ void done(const Unit&) const {}
};
typedef __bf16 bf16x2_t __attribute__((ext_vector_type(2)));
typedef float f32x2_t __attribute__((ext_vector_type(2)));
__device__ __forceinline__ unsigned cvt_pk_bf16(float lo, float hi) { f32x2_t v = {lo, hi}; bf16x2_t b = __builtin_convertvector(v, bf16x2_t); return __builtin_bit_cast(unsigned, b); }

template <class Epi, class Sched, bool ALIGN_EPI = false, bool SP2 = false>
__device__ __forceinline__ void gemm_phase(PG8_LAS unsigned char* lds, const Gemm g, const Sched& S, const Epi& E, const int tid) {
    const int wid = __builtin_amdgcn_readfirstlane(tid >> 6), lane = tid & 63, wr = wid >> 2, wc = wid & 3, fr = lane & 15, fq = lane >> 4;
    const int K = g.K, nt = K / BK;
    unsigned voffA[2], voffB[2];
#pragma unroll
    for (int i = 0; i < 2; ++i) { int R, C; stage_rc(tid * 16 + i * 8192, R, C); const int Rb = Epi::PERM ? ((R & ~31) + perm32(R & 31)) : R;
        voffA[i] = (unsigned)(R * K + C) * 2u; voffB[i] = (unsigned)(Rb * K + C) * 2u; }
    const size_t kstep = (size_t)(BK * 2);
    const size_t hstep = (size_t)HALF * K * 2;
    const size_t tstep = 2 * hstep;
    const unsigned ldsw = (unsigned)wid * 1024u;
    const int aoff = lds_byte(wr * 64 + fr, fq * 8), boff = lds_byte(wc * 32 + fr, fq * 8);
#define PG8_SA(b, h) (((b) * 2 + (h)) * HTB)
#define PG8_SB(b, h) ((4 + (b) * 2 + (h)) * HTB)
#define PG8_STAGE(bufoff, gbase, voff) do { _Pragma("unroll") for (int _i = 0; _i < 2; ++_i) \
        __builtin_amdgcn_global_load_lds((const unsigned*)((const char*)(gbase) + (voff)[_i]), (PG8_LAS unsigned*)(lds + (bufoff) + ldsw + _i * 8192), 16, 0, 0); } while (0)
#define PG8_LDA(dst, b, h) do { _Pragma("unroll") for (int m = 0; m < 4; ++m) _Pragma("unroll") for (int k = 0; k < 2; ++k) dst[m][k] = *(const PG8_LAS bf16x8*)(lds + PG8_SA(b, h) + aoff + m * 2048 + k * 1024); } while (0)
#define PG8_LDB(dst, b, h) do { _Pragma("unroll") for (int n = 0; n < 2; ++n) _Pragma("unroll") for (int k = 0; k < 2; ++k) dst[n][k] = *(const PG8_LAS bf16x8*)(lds + PG8_SB(b, h) + boff + n * 2048 + k * 1024); } while (0)
#define PG8_MMA(ai, bj, At, Bt) do { __builtin_amdgcn_s_setprio(1); _Pragma("unroll") for (int m = 0; m < 4; ++m) _Pragma("unroll") for (int n = 0; n < 2; ++n) _Pragma("unroll") for (int k = 0; k < 2; ++k) \
        acc[ai][bj][m][n] = __builtin_amdgcn_mfma_f32_16x16x32_bf16(Bt[n][k], At[m][k], acc[ai][bj][m][n], 0, 0, 0); __builtin_amdgcn_s_setprio(0); } while (0)
#define PG8_WAIT_V(n) asm volatile("s_waitcnt vmcnt(" #n ")" ::: "memory")
#define PG8_WAIT_L(n) asm volatile("s_waitcnt lgkmcnt(" #n ")" ::: "memory")
#define PG8_BAR __builtin_amdgcn_s_barrier()
#define PG8_SCHED __builtin_amdgcn_sched_barrier(0)
    Unit cur, nxt; int ui = 0;
    if (!S.next(0, cur)) return;
    f32x4 acc[2][2][4][2];
#pragma unroll
    for (int a = 0; a < 2; ++a)
#pragma unroll
        for (int b = 0; b < 2; ++b)
#pragma unroll
            for (int m = 0; m < 4; ++m)
#pragma unroll
                for (int n = 0; n < 2; ++n) acc[a][b][m][n] = (f32x4){0.f, 0.f, 0.f, 0.f};
    bf16x8 At[4][2], B0[2][2], B1[2][2];
    const char* cA = (const char*)g.A + (size_t)cur.pm * tstep; const char* cB = (const char*)g.Bt + (size_t)cur.pn * tstep;
    S.a_ready(cur);
    if constexpr (SP2) {
        PG8_STAGE(PG8_SB(0, 0), cB, voffB); PG8_STAGE(PG8_SB(0, 1), cB + hstep, voffB); PG8_STAGE(PG8_SA(0, 0), cA, voffA); PG8_STAGE(PG8_SA(0, 1), cA + hstep, voffA);
        if (wr == 1) PG8_BAR;
        PG8_WAIT_V(2); PG8_BAR;
        PG8_STAGE(PG8_SB(1, 0), cB + kstep, voffB); PG8_STAGE(PG8_SA(1, 0), cA + kstep, voffA); PG8_STAGE(PG8_SB(1, 1), cB + hstep + kstep, voffB);
        PG8_WAIT_V(6); PG8_BAR;
    } else {
        PG8_STAGE(PG8_SB(0, 0), cB, voffB); PG8_STAGE(PG8_SA(0, 0), cA, voffA); PG8_STAGE(PG8_SB(0, 1), cB + hstep, voffB); PG8_STAGE(PG8_SA(0, 1), cA + hstep, voffA);
        if (wr == 1) PG8_BAR;
        PG8_WAIT_V(4); PG8_BAR;
        PG8_STAGE(PG8_SB(1, 0), cB + kstep, voffB); PG8_STAGE(PG8_SA(1, 0), cA + kstep, voffA); PG8_STAGE(PG8_SB(1, 1), cB + hstep + kstep, voffB);
        PG8_WAIT_V(6); PG8_BAR;
    }
    for (;;) {
        const bool has_next = S.next(ui + 1, nxt);
        const char* nA = has_next ? (const char*)g.A + (size_t)nxt.pm * tstep : cA; const char* nB = has_next ? (const char*)g.Bt + (size_t)nxt.pn * tstep : cB;
        for (int t = 0; t < nt; t += 2) {
            const bool last = (t == nt - 2);
            const char* a1 = cA + (size_t)(t + 1) * kstep;
            const char* a2 = last ? nA : cA + (size_t)(t + 2) * kstep; const char* b2 = last ? nB : cB + (size_t)(t + 2) * kstep;
            const char* a3 = a2 + kstep; const char* b3 = b2 + kstep;
            if (last && has_next) S.a_ready(nxt);
            if constexpr (SP2) {
            PG8_LDB(B0, 0, 0); PG8_LDB(B1, 0, 1); PG8_SCHED; PG8_LDA(At, 0, 0); PG8_STAGE(PG8_SA(1, 1), a1 + hstep, voffA);
            PG8_WAIT_V(8); PG8_WAIT_L(0); PG8_BAR; PG8_MMA(0, 0, At, B0); PG8_MMA(0, 1, At, B1); PG8_BAR; PG8_SCHED;
            PG8_LDA(At, 0, 1); PG8_STAGE(PG8_SB(0, 0), b2, voffB); PG8_STAGE(PG8_SB(0, 1), b2 + hstep, voffB); PG8_STAGE(PG8_SA(0, 0), a2, voffA);
            PG8_WAIT_V(8); PG8_WAIT_L(0); PG8_BAR; PG8_MMA(1, 0, At, B0); PG8_MMA(1, 1, At, B1); PG8_BAR; PG8_SCHED;
            PG8_LDB(B0, 1, 0); PG8_LDB(B1, 1, 1); PG8_SCHED; PG8_LDA(At, 1, 0); PG8_STAGE(PG8_SA(0, 1), a2 + hstep, voffA);
            PG8_WAIT_V(8); PG8_WAIT_L(0); PG8_BAR; PG8_MMA(0, 0, At, B0); PG8_MMA(0, 1, At, B1); PG8_BAR; PG8_SCHED;
            PG8_LDA(At, 1, 1); PG8_STAGE(PG8_SB(1, 0), b3, voffB); PG8_STAGE(PG8_SB(1, 1), b3 + hstep, voffB); PG8_STAGE(PG8_SA(1, 0), a3, voffA);
            PG8_WAIT_V(8); PG8_WAIT_L(0); PG8_BAR; PG8_MMA(1, 0, At, B0); PG8_MMA(1, 1, At, B1); PG8_BAR; PG8_SCHED;
            } else {
            PG8_LDB(B0, 0, 0); PG8_SCHED; PG8_LDA(At, 0, 0); PG8_STAGE(PG8_SA(1, 1), a1 + hstep, voffA);
            PG8_WAIT_L(8); PG8_BAR; PG8_WAIT_L(0); PG8_MMA(0, 0, At, B0); PG8_BAR; PG8_SCHED;
            PG8_LDB(B1, 0, 1); PG8_STAGE(PG8_SB(0, 0), b2, voffB);
            PG8_BAR; PG8_WAIT_L(0); PG8_MMA(0, 1, At, B1); PG8_BAR;
            PG8_LDA(At, 0, 1); PG8_STAGE(PG8_SA(0, 0), a2, voffA);
            PG8_BAR; PG8_WAIT_L(0); PG8_MMA(1, 0, At, B0); PG8_BAR; PG8_SCHED;
            PG8_STAGE(PG8_SB(0, 1), b2 + hstep, voffB);
            PG8_WAIT_V(6); PG8_BAR; PG8_MMA(1, 1, At, B1); PG8_BAR;
            PG8_LDB(B0, 1, 0); PG8_SCHED; PG8_LDA(At, 1, 0); PG8_STAGE(PG8_SA(0, 1), a2 + hstep, voffA);
            PG8_WAIT_L(8); PG8_BAR; PG8_WAIT_L(0); PG8_MMA(0, 0, At, B0); PG8_BAR; PG8_SCHED;
            PG8_LDB(B1, 1, 1); PG8_STAGE(PG8_SB(1, 0), b3, voffB);
            PG8_BAR; PG8_WAIT_L(0); PG8_MMA(0, 1, At, B1); PG8_BAR;
            PG8_LDA(At, 1, 1); PG8_STAGE(PG8_SA(1, 0), a3, voffA);
            PG8_BAR; PG8_WAIT_L(0); PG8_MMA(1, 0, At, B0); PG8_BAR; PG8_SCHED;
            PG8_STAGE(PG8_SB(1, 1), b3 + hstep, voffB);
            PG8_WAIT_V(6); PG8_BAR; PG8_MMA(1, 1, At, B1); PG8_BAR;
            }
        }
        if constexpr (ALIGN_EPI) { if (wr == 0) PG8_BAR; }
        if constexpr (!Epi::AFTER_DRAIN) { E(acc, cur, wr, wc, fr, fq); S.done(cur); }
        if (!has_next) break;
#pragma unroll
        for (int a = 0; a < 2; ++a)
#pragma unroll
            for (int b = 0; b < 2; ++b)
#pragma unroll
                for (int m = 0; m < 4; ++m)
#pragma unroll
                    for (int n = 0; n < 2; ++n) acc[a][b][m][n] = (f32x4){0.f, 0.f, 0.f, 0.f};
        cur = nxt; cA = nA; cB = nB; ++ui;
        if constexpr (ALIGN_EPI) { if (wr == 1) PG8_BAR; }
    }
    PG8_WAIT_V(0);
    if constexpr (!ALIGN_EPI) { if (wr == 0) PG8_BAR; }
    PG8_BAR;
    if constexpr (Epi::AFTER_DRAIN) { E.fused(acc, cur, wr, wc, fr, fq, lds, wid, lane); S.done(cur); }
#undef PG8_SA
#undef PG8_SB
#undef PG8_STAGE
#undef PG8_LDA
#undef PG8_LDB
#undef PG8_MMA
#undef PG8_WAIT_V
#undef PG8_WAIT_L
#undef PG8_BAR
#undef PG8_SCHED
}
}

#define LAS __attribute__((address_space(3)))
typedef unsigned short bf16_t;
typedef short bf16x8 __attribute__((ext_vector_type(8)));
typedef short s16x4 __attribute__((ext_vector_type(4)));
typedef float f32x4 __attribute__((ext_vector_type(4)));
typedef float f32x2 __attribute__((ext_vector_type(2)));
typedef float f32x16 __attribute__((ext_vector_type(16)));
typedef unsigned u32x4 __attribute__((ext_vector_type(4)));
typedef unsigned u32x2 __attribute__((ext_vector_type(2)));
using pg8::Unit;

constexpr int NWAVES = 8, NTHREADS = 512;
constexpr int SEQ = 4096, DM = 1024, MTOK = 8 * SEQ;
constexpr int N1 = 6144, N3 = 1792, QROW = 1536;
constexpr float RMS_EPS = 1e-6f;
constexpr int LDS_BYTES = 163840;

constexpr size_t MiB = 1u << 20;
constexpr size_t WS_CTL = 0, WS_TABA = 1 * MiB, WS_TABB = 3 * MiB;
constexpr size_t WS_W1 = 4 * MiB, WS_W2 = 16 * MiB, WS_W3 = 20 * MiB, WS_WUQ = 24 * MiB, WS_WKV = 26 * MiB, WS_W5 = 27 * MiB;
constexpr size_t WS_XN = 32 * MiB, WS_Q = 96 * MiB, WS_K = 160 * MiB, WS_V = 224 * MiB, WS_G = 352 * MiB, WS_L = 480 * MiB;
constexpr size_t WS_Y1 = WS_Q, WS_H1 = WS_V, WS_XN2 = WS_XN, WS_SG2 = WS_K;
constexpr size_t WS_CQ = 352 * MiB, WS_CKV = 376 * MiB, WS_KRR = 392 * MiB, WS_PQ = 400 * MiB, WS_PKV = 402 * MiB, WS_KR = 404 * MiB, WS_QM = 408 * MiB;
constexpr size_t WS_KN = WS_XN, WS_V2 = WS_Q, WS_Y2 = WS_XN;
constexpr size_t WS_NEED = 512 * MiB;

struct Args { const float* in[17]; float* out; unsigned char* ws; int ph_lo, ph_hi; };

__device__ __forceinline__ unsigned pk2(float lo, float hi) { return pg8::cvt_pk_bf16(lo, hi); }
__device__ __forceinline__ float bf_lo(unsigned w) { return __uint_as_float(w << 16); }
__device__ __forceinline__ float bf_hi(unsigned w) { return __uint_as_float(w & 0xffff0000u); }
__device__ __forceinline__ float bf1(bf16_t v) { return __uint_as_float(((unsigned)v) << 16); }
__device__ __forceinline__ float wave_sum(float v) {
#pragma unroll
    for (int o = 1; o < 64; o <<= 1) v += __shfl_xor(v, o);
    return v;
}
__device__ __forceinline__ float silu_f(float x) { return x * __builtin_amdgcn_rcpf(1.0f + __expf(-x)); }
__device__ __forceinline__ int crow(int r, int hi) { return (r & 3) + 8 * (r >> 2) + 4 * hi; }
#define LDS_WAIT() asm volatile("s_waitcnt lgkmcnt(0)" ::: "memory")
#define SBAR() __builtin_amdgcn_sched_barrier(0)

__device__ __forceinline__ void p0_item(const float* __restrict__ W, int N, int K, const float* __restrict__ gain, bf16_t* WT, int k0, int sc, int n0, LAS float* scr, int lane) {
    if (sc >= 0) {
        float wv[32], gv[32];
#pragma unroll
        for (int i = 0; i < 32; ++i) { const int kk = 2 * i + (lane >> 5); wv[i] = W[(size_t)(k0 + kk) * N + sc + (lane & 31)]; gv[i] = gain ? gain[k0 + kk] : 1.0f; }
#pragma unroll
        for (int i = 0; i < 32; ++i) { const int kk = 2 * i + (lane >> 5); scr[kk * 33 + (lane & 31)] = wv[i] * gv[i]; }
    } else {
#pragma unroll 8
        for (int i = 0; i < 32; ++i) { const int kk = 2 * i + (lane >> 5); scr[kk * 33 + (lane & 31)] = 0.0f; }
    }
    LDS_WAIT(); asm volatile("" ::: "memory");
    const int c = lane & 7;
#pragma unroll
    for (int j = 0; j < 4; ++j) { const int n = (lane >> 3) + 8 * j; const LAS float* s = scr + (8 * c) * 33 + n;
        u32x4 o; o.x = pk2(s[0 * 33], s[1 * 33]); o.y = pk2(s[2 * 33], s[3 * 33]); o.z = pk2(s[4 * 33], s[5 * 33]); o.w = pk2(s[6 * 33], s[7 * 33]);
        *(u32x4*)(WT + (size_t)(n0 + n) * K + k0 + 8 * c) = o; }
    LDS_WAIT(); asm volatile("" ::: "memory");
}
__device__ __forceinline__ void p0_prologue(const Args& a, LAS unsigned char* lds, int gw, int NGW, int wave, int lane) {
    unsigned char* ws = a.ws;
    LAS float* scr = (LAS float*)(lds + wave * 16384);
    constexpr int I1 = 16 * 192, I2 = 32 * 32, I3 = 16 * 56, I4 = 6 * 48, I5 = 4 * 64, I6 = 16 * 32;
    for (int it = gw; it < I1 + I2 + I3 + I4 + I5 + I6; it += NGW) {
        int r = it;
        if (r < I1) {
            const int kb = r / 192, n = 32 * (r % 192); int sc;
            if (n < 2048) { const int region = n >> 10, tq = (n & 1023) >> 8, j = n & 255, head = 2 * tq + ((j >> 6) & 1), d = (j & 63) + 64 * (j >> 7); sc = region * 1024 + head * 128 + d; } else sc = n;
            p0_item(a.in[2], 6144, 1024, a.in[1], (bf16_t*)(ws + WS_W1), kb * 64, sc, n, scr, lane); continue; }
        r -= I1;
        if (r < I2) {
            const int kb = r / 32, n = 32 * (r % 32);
            p0_item(a.in[4], 1024, 2048, a.in[3], (bf16_t*)(ws + WS_W2), kb * 64, n, n, scr, lane); continue; }
        r -= I2;
        if (r < I3) {
            const int kb = r / 56, n = 32 * (r % 56);
            if (n < 1024)      p0_item(a.in[12], 1408, 1024, a.in[11], (bf16_t*)(ws + WS_W3), kb * 64, 384 + n, n, scr, lane);
            else if (n < 1408) p0_item(a.in[12], 1408, 1024, a.in[11], (bf16_t*)(ws + WS_W3), kb * 64, n - 1024, n, scr, lane);
            else if (n < 1664) p0_item(a.in[7], 320, 1024, a.in[6], (bf16_t*)(ws + WS_W3), kb * 64, n - 1408, n, scr, lane);
            else if (n < 1728) p0_item(a.in[7], 320, 1024, a.in[6], (bf16_t*)(ws + WS_W3), kb * 64, 256 + (n - 1664), n, scr, lane);
            else               p0_item(a.in[7], 320, 1024, a.in[6], (bf16_t*)(ws + WS_W3), kb * 64, -1, n, scr, lane);
            continue; }
        r -= I3;
        if (r < I4) {
            const int kb = r / 48, n = 32 * (r % 48); const int sc = n;
            p0_item(a.in[14], 1536, 384, a.in[13], (bf16_t*)(ws + WS_WUQ), kb * 64, sc, n, scr, lane); continue; }
        r -= I4;
        if (r < I5) {
            const int kb = r / 64, n = 32 * (r % 64);
            if (n < 1024) p0_item(a.in[9], 1024, 256, a.in[8], (bf16_t*)(ws + WS_WKV), kb * 64, n, n, scr, lane);
            else          p0_item(a.in[10], 1024, 256, a.in[8], (bf16_t*)(ws + WS_WKV), kb * 64, n - 1024, n, scr, lane);
            continue; }
        r -= I5;
        { const int kb = r / 32, n = 32 * (r % 32);
          p0_item(a.in[15], 1024, 1024, nullptr, (bf16_t*)(ws + WS_W5), kb * 64, n, n, scr, lane); }
    }
    {
        f32x2* tA = (f32x2*)(ws + WS_TABA); f32x2* tB = (f32x2*)(ws + WS_TABB);
        const int gt = gw * 64 + lane, NT = NGW * 64;
        for (int i = gt; i < 4096 * 64; i += NT) { const int pos = i >> 6, d = i & 63; const float inv = powf(10000.0f, -(float)d / 64.0f); float s, c; sincosf((float)pos * inv, &s, &c); tA[i] = (f32x2){c, s}; }
        for (int i = gt; i < 4096 * 32; i += NT) { const int pos = i >> 5, d = i & 31; const float inv = powf(10000.0f, -(float)d / 32.0f); float s, c; sincosf((float)pos * inv, &s, &c); tB[i] = (f32x2){c, s}; }
    }
    {
        const float* x = a.in[0]; bf16_t* xn = (bf16_t*)(ws + WS_XN);
        for (int m = gw; m < MTOK; m += NGW) {
            const f32x4* xr = (const f32x4*)(x + (size_t)m * DM) + lane; f32x4 v[4]; float s = 0.f;
#pragma unroll
            for (int j = 0; j < 4; ++j) { v[j] = xr[64 * j]; s += (v[j].x * v[j].x + v[j].y * v[j].y) + (v[j].z * v[j].z + v[j].w * v[j].w); }
            const float rs = 1.0f / sqrtf(wave_sum(s) * (1.0f / DM) + RMS_EPS);
            u32x2* o = (u32x2*)(xn + (size_t)m * DM) + lane;
#pragma unroll
            for (int j = 0; j < 4; ++j) { u32x2 w; w.x = pk2(v[j].x * rs, v[j].y * rs); w.y = pk2(v[j].z * rs, v[j].w * rs); o[64 * j] = w; }
        }
    }
}

__device__ __forceinline__ u32x4 pack8(const f32x4 a, const f32x4 b) { u32x4 w; w.x = pk2(a[0], a[1]); w.y = pk2(a[2], a[3]); w.z = pk2(b[0], b[1]); w.w = pk2(b[2], b[3]); return w; }

struct EpiP1 {
    static constexpr bool PERM = true, AFTER_DRAIN = false;
    bf16_t *q, *k, *v, *sg; const f32x4* tabA;
    __device__ __forceinline__ void operator()(const f32x4 (&acc)[2][2][4][2], const Unit& u, int wr, int wc, int fr, int fq) const {
        const int pn = u.pn, row0 = u.pm * 256 + wr * 64 + fr;
        if (pn < 8) {
            const int region = pn >> 2, tq = pn & 3, head = 2 * tq + (wc >> 1), d0 = 32 * (wc & 1) + 8 * fq;
            bf16_t* dst = region ? k : q;
            const float l2g = log2f(1.0f - exp2f(-5.0f - (float)head));
            f32x4 tn[4];
            { const f32x4* tp = tabA + ((size_t)(row0 & 4095) * 64 + d0) / 2; tn[0] = tp[0]; tn[1] = tp[1]; tn[2] = tp[2]; tn[3] = tp[3]; }
#pragma unroll
            for (int idx = 0; idx < 8; ++idx) {
                const int ai = idx >> 2, m = idx & 3;
                int row = row0 + ai * 128 + m * 16; asm volatile("" : "+v"(row)); const int n = row & 63;
                const f32x4 t0 = tn[0], t1 = tn[1], t2 = tn[2], t3 = tn[3];
                if (idx < 7) { const int nrow = row0 + ((idx + 1) >> 2) * 128 + ((idx + 1) & 3) * 16; const f32x4* tp = tabA + ((size_t)(nrow & 4095) * 64 + d0) / 2; tn[0] = tp[0]; tn[1] = tp[1]; tn[2] = tp[2]; tn[3] = tp[3]; }
                const float sc = region ? 0.08838834764831845f * exp2f(l2g * (float)(63 - n)) : exp2f(l2g * (float)(n + 1));
                const f32x4 xa = acc[ai][0][m][0], xb = acc[ai][0][m][1], ya = acc[ai][1][m][0], yb = acc[ai][1][m][1];
                f32x4 oa, ob, pa, pb;
                oa[0] = (xa[0] * t0[0] - ya[0] * t0[1]) * sc; pa[0] = (xa[0] * t0[1] + ya[0] * t0[0]) * sc;
                oa[1] = (xa[1] * t0[2] - ya[1] * t0[3]) * sc; pa[1] = (xa[1] * t0[3] + ya[1] * t0[2]) * sc;
                oa[2] = (xa[2] * t1[0] - ya[2] * t1[1]) * sc; pa[2] = (xa[2] * t1[1] + ya[2] * t1[0]) * sc;
                oa[3] = (xa[3] * t1[2] - ya[3] * t1[3]) * sc; pa[3] = (xa[3] * t1[3] + ya[3] * t1[2]) * sc;
                ob[0] = (xb[0] * t2[0] - yb[0] * t2[1]) * sc; pb[0] = (xb[0] * t2[1] + yb[0] * t2[0]) * sc;
                ob[1] = (xb[1] * t2[2] - yb[1] * t2[3]) * sc; pb[1] = (xb[1] * t2[3] + yb[1] * t2[2]) * sc;
                ob[2] = (xb[2] * t3[0] - yb[2] * t3[1]) * sc; pb[2] = (xb[2] * t3[1] + yb[2] * t3[0]) * sc;
                ob[3] = (xb[3] * t3[2] - yb[3] * t3[3]) * sc; pb[3] = (xb[3] * t3[3] + yb[3] * t3[2]) * sc;
                bf16_t* rp = dst + (size_t)row * 1024 + head * 128 + d0;
                *(u32x4*)rp = pack8(oa, ob); *(u32x4*)(rp + 64) = pack8(pa, pb);
            }
        } else if (pn < 16) {
            const int col0 = (pn - 8) * 256 + wc * 32 + 8 * fq;
#pragma unroll
            for (int ai = 0; ai < 2; ++ai)
#pragma unroll
                for (int m = 0; m < 4; ++m) { bf16_t* rp = v + (size_t)(row0 + ai * 128 + m * 16) * 2048 + col0;
#pragma unroll
                    for (int bj = 0; bj < 2; ++bj) *(u32x4*)(rp + bj * 128) = pack8(acc[ai][bj][m][0], acc[ai][bj][m][1]); }
        } else {
            const int col0 = (pn - 16) * 256 + wc * 32 + 8 * fq;
#pragma unroll
            for (int ai = 0; ai < 2; ++ai)
#pragma unroll
                for (int m = 0; m < 4; ++m) { bf16_t* rp = sg + (size_t)(row0 + ai * 128 + m * 16) * 2048 + col0;
#pragma unroll
                    for (int bj = 0; bj < 2; ++bj) { f32x4 a0 = acc[ai][bj][m][0], a1 = acc[ai][bj][m][1];
#pragma unroll
                        for (int j = 0; j < 4; ++j) { a0[j] = silu_f(a0[j]); a1[j] = silu_f(a1[j]); }
                        *(u32x4*)(rp + bj * 128) = pack8(a0, a1); } }
        }
    }
};

struct EpiPlain {
    static constexpr bool PERM = true, AFTER_DRAIN = false;
    bf16_t* O; int ldc;
    __device__ __forceinline__ void operator()(const f32x4 (&acc)[2][2][4][2], const Unit& u, int wr, int wc, int fr, int fq) const {
        const int row0 = u.pm * 256 + wr * 64 + fr, col0 = u.pn * 256 + wc * 32 + 8 * fq;
#pragma unroll
        for (int ai = 0; ai < 2; ++ai)
#pragma unroll
            for (int m = 0; m < 4; ++m) { bf16_t* rp = O + (size_t)(row0 + ai * 128 + m * 16) * ldc + col0;
#pragma unroll
                for (int bj = 0; bj < 2; ++bj) *(u32x4*)(rp + bj * 128) = pack8(acc[ai][bj][m][0], acc[ai][bj][m][1]); }
    }
};

struct EpiP4 {
    static constexpr bool PERM = true, AFTER_DRAIN = false;
    bf16_t *sg2, *cq, *ckv; float *krr, *pq, *pkv;
    __device__ __forceinline__ void operator()(const f32x4 (&acc)[2][2][4][2], const Unit& u, int wr, int wc, int fr, int fq) const {
        const int row0 = u.pm * 256 + wr * 64 + fr, c0 = wc * 32 + 8 * fq;
#pragma unroll
        for (int bj = 0; bj < 2; ++bj) {
            const int hh = 2 * u.pn + bj;
            if (hh < 8) {
#pragma unroll
                for (int ai = 0; ai < 2; ++ai)
#pragma unroll
                    for (int m = 0; m < 4; ++m) { f32x4 a0 = acc[ai][bj][m][0], a1 = acc[ai][bj][m][1];
#pragma unroll
                        for (int j = 0; j < 4; ++j) { a0[j] = silu_f(a0[j]); a1[j] = silu_f(a1[j]); }
                        *(u32x4*)(sg2 + (size_t)(row0 + ai * 128 + m * 16) * 1024 + hh * 128 + c0) = pack8(a0, a1); }
            } else if (hh < 13) {
                const bool isq = hh < 11; const int hq = isq ? hh - 8 : hh - 11, ld = isq ? 384 : 256, nslot = isq ? 12 : 8;
                bf16_t* dst = isq ? cq : ckv; float* pp = isq ? pq : pkv;
#pragma unroll
                for (int ai = 0; ai < 2; ++ai)
#pragma unroll
                    for (int m = 0; m < 4; ++m) { int row = row0 + ai * 128 + m * 16; asm volatile("" : "+v"(row)); const f32x4 a0 = acc[ai][bj][m][0], a1 = acc[ai][bj][m][1];
                        *(u32x4*)(dst + (size_t)row * ld + hq * 128 + c0) = pack8(a0, a1);
                        float s = (a0[0] * a0[0] + a0[1] * a0[1]) + (a0[2] * a0[2] + a0[3] * a0[3]) + (a1[0] * a1[0] + a1[1] * a1[1]) + (a1[2] * a1[2] + a1[3] * a1[3]);
                        s += __shfl_xor(s, 16); s += __shfl_xor(s, 32);
                        if (fq == 0) pp[(size_t)row * nslot + hq * 4 + wc] = s; }
            } else {
                if (wc < 2) {
#pragma unroll
                    for (int ai = 0; ai < 2; ++ai)
#pragma unroll
                        for (int m = 0; m < 4; ++m) { float* rp = krr + (size_t)(row0 + ai * 128 + m * 16) * 64 + c0;
                            *(f32x4*)rp = acc[ai][bj][m][0]; *(f32x4*)(rp + 4) = acc[ai][bj][m][1]; }
                }
            }
        }
    }
};

struct EpiP5kv {
    static constexpr bool PERM = true, AFTER_DRAIN = false;
    bf16_t *kn, *v2; const float* pkv;
    __device__ __forceinline__ void operator()(const f32x4 (&acc)[2][2][4][2], const Unit& u, int wr, int wc, int fr, int fq) const {
        const int row0 = u.pm * 256 + wr * 64 + fr; bf16_t* dst = (u.pn < 4) ? kn : v2; const int col0 = (u.pn & 3) * 256 + wc * 32 + 8 * fq;
#pragma unroll
        for (int ai = 0; ai < 2; ++ai) {
            float rsv[4];
#pragma unroll
            for (int m = 0; m < 4; ++m) { const int row = row0 + ai * 128 + m * 16; const f32x4* pp = (const f32x4*)(pkv + (size_t)row * 8);
                const f32x4 p0 = pp[0], p1 = pp[1];
                const float ss = ((p0[0] + p0[1]) + (p0[2] + p0[3])) + ((p1[0] + p1[1]) + (p1[2] + p1[3]));
                rsv[m] = 1.0f / sqrtf(ss * (1.0f / 256.0f) + RMS_EPS); }
#pragma unroll
            for (int m = 0; m < 4; ++m) {
                int row = row0 + ai * 128 + m * 16; asm volatile("" : "+v"(row));
                bf16_t* rp = dst + (size_t)row * 1024 + col0; const float rs = rsv[m];
#pragma unroll
                for (int bj = 0; bj < 2; ++bj) *(u32x4*)(rp + bj * 128) = pack8(acc[ai][bj][m][0] * rs, acc[ai][bj][m][1] * rs);
            }
            asm volatile("" ::: "memory");
        }
    }
};

template <bool BASE_BF16, bool OUT_BF16, bool WITH_XN>
__device__ __forceinline__ void row_phase(const bf16_t* __restrict__ y, const void* __restrict__ base, const float* __restrict__ gpost, void* outp, bf16_t* xn, int gw, int NGW, int lane) {
    f32x4 g[2][2];
#pragma unroll
    for (int j = 0; j < 2; ++j) { const f32x4* gp = (const f32x4*)(gpost + 8 * lane + 512 * j); g[j][0] = gp[0]; g[j][1] = gp[1]; }
    for (int m0 = gw; m0 < MTOK; m0 += 2 * NGW) {
        u32x4 yw[2][2]; float xb[2][2][8];
#pragma unroll
        for (int r = 0; r < 2; ++r) { const int m = m0 + r * NGW;
#pragma unroll
            for (int j = 0; j < 2; ++j) { const size_t off = (size_t)m * DM + 8 * lane + 512 * j;
                yw[r][j] = *(const u32x4*)(y + off);
                if (BASE_BF16) { const u32x4 bw = *(const u32x4*)((const bf16_t*)base + off);
#pragma unroll
                    for (int q = 0; q < 4; ++q) { xb[r][j][2 * q] = bf_lo(bw[q]); xb[r][j][2 * q + 1] = bf_hi(bw[q]); } }
                else { const f32x4* bp = (const f32x4*)((const float*)base + off); const f32x4 b0 = bp[0], b1 = bp[1];
#pragma unroll
                    for (int q = 0; q < 4; ++q) { xb[r][j][q] = b0[q]; xb[r][j][4 + q] = b1[q]; } } } }
#pragma unroll
        for (int r = 0; r < 2; ++r) { const int m = m0 + r * NGW;
            float yv[2][8]; float s = 0.f;
#pragma unroll
            for (int j = 0; j < 2; ++j) {
#pragma unroll
                for (int q = 0; q < 4; ++q) { yv[j][2 * q] = bf_lo(yw[r][j][q]); yv[j][2 * q + 1] = bf_hi(yw[r][j][q]); }
#pragma unroll
                for (int q = 0; q < 8; ++q) s += yv[j][q] * yv[j][q]; }
            const float rs = 1.0f / sqrtf(wave_sum(s) * (1.0f / DM) + RMS_EPS);
            float hv[2][8]; float s2 = 0.f;
#pragma unroll
            for (int j = 0; j < 2; ++j)
#pragma unroll
                for (int q = 0; q < 8; ++q) { hv[j][q] = xb[r][j][q] + yv[j][q] * rs * g[j][q >> 2][q & 3]; s2 += hv[j][q] * hv[j][q]; }
#pragma unroll
            for (int j = 0; j < 2; ++j) { const size_t off = (size_t)m * DM + 8 * lane + 512 * j;
                if (OUT_BF16) { u32x4 w; w.x = pk2(hv[j][0], hv[j][1]); w.y = pk2(hv[j][2], hv[j][3]); w.z = pk2(hv[j][4], hv[j][5]); w.w = pk2(hv[j][6], hv[j][7]); *(u32x4*)((bf16_t*)outp + off) = w; }
                else { f32x4* op = (f32x4*)((float*)outp + off); op[0] = (f32x4){hv[j][0], hv[j][1], hv[j][2], hv[j][3]}; op[1] = (f32x4){hv[j][4], hv[j][5], hv[j][6], hv[j][7]}; } }
            if (WITH_XN) {
                const float rs2 = 1.0f / sqrtf(wave_sum(s2) * (1.0f / DM) + RMS_EPS);
#pragma unroll
                for (int j = 0; j < 2; ++j) { u32x4 w; w.x = pk2(hv[j][0] * rs2, hv[j][1] * rs2); w.y = pk2(hv[j][2] * rs2, hv[j][3] * rs2); w.z = pk2(hv[j][4] * rs2, hv[j][5] * rs2); w.w = pk2(hv[j][6] * rs2, hv[j][7] * rs2);
                    *(u32x4*)(xn + (size_t)m * DM + 8 * lane + 512 * j) = w; }
            }
        }
    }
}

namespace ret {
constexpr int QS_STRIDE = 272, KS_STRIDE = 320, VS_STRIDE = 576, RT_STRIDE = 272, SS_STRIDE = 144, OS_STRIDE = 528;
constexpr int R_QS = 0, R_KS = 17408, R_VS = 37888, R_RT = 74752, R_SS = 144384, R_ST = 153600, R_END = 157696, R_OS = 0;
static_assert(R_END <= LDS_BYTES && 64 * OS_STRIDE <= R_VS, "retention LDS map");

__device__ __forceinline__ s16x4 trr(unsigned addr) { s16x4 r; asm volatile("ds_read_b64_tr_b16 %0, %1" : "=&v"(r) : "v"(addr) : "memory"); return r; }
#define RET_PK(L, H) (bf16x8){L[0], L[1], L[2], L[3], H[0], H[1], H[2], H[3]}
#define MFMA32(a, b, c) __builtin_amdgcn_mfma_f32_32x32x16_bf16((a), (b), (c), 0, 0, 0)

template <bool PRE>
__device__ __forceinline__ void ret_item(LAS unsigned char* lds, const bf16_t* __restrict__ Qg, const bf16_t* __restrict__ Kg, const bf16_t* __restrict__ Vg, bf16_t* SGg, float* Lbuf,
                                         int bh, int g, int tid_in, int wid, int lane_in, bf16_t* OUTg, int rowmask) {
    const int b = bh >> 3, h = bh & 7;
    const float l2g = log2f(1.0f - exp2f(-5.0f - (float)h));
    const float gc = exp2f(l2g * 64.0f);
    const int tok_seg0 = b * SEQ + g * 1024;
    const unsigned ldsb = (unsigned)(size_t)lds;
    f32x16 R[4];
#pragma unroll
    for (int dt = 0; dt < 4; ++dt)
#pragma unroll
        for (int r = 0; r < 16; ++r) R[dt][r] = 0.f;
    if (!PRE) {
        const int lane = lane_in, r32 = lane & 31, hi = lane >> 5;
        if (g > 0) {
            const float c16 = exp2f(l2g * 1024.0f); float coef = 1.0f;
            for (int gp = g - 1; gp >= 0; --gp) {
                const float* lp = Lbuf + ((size_t)(bh * 3 + gp) * 8 + wid) * 4096 + lane;
#pragma unroll
                for (int dt = 0; dt < 4; ++dt)
#pragma unroll
                    for (int r = 0; r < 16; ++r) R[dt][r] += coef * lp[(dt * 16 + r) * 64];
                coef *= c16;
            }
        }
#pragma unroll
        for (int dt = 0; dt < 4; ++dt)
#pragma unroll
            for (int gq = 0; gq < 4; ++gq) { u32x2 w; w.x = pk2(R[dt][4 * gq], R[dt][4 * gq + 1]); w.y = pk2(R[dt][4 * gq + 2], R[dt][4 * gq + 3]);
                *(LAS u32x2*)(lds + R_RT + (32 * wid + r32) * RT_STRIDE + (32 * dt + 8 * gq + 4 * hi) * 2) = w; }
    }
    u32x4 sq[2], sk[2], sv[4];
#define RET_LOAD(tok0) do { \
        _Pragma("unroll") for (int j_ = 0; j_ < 2; ++j_) { const int c = tid + 512 * j_, row = c >> 4, ch = c & 15; \
            if (!PRE) sq[j_] = *(const u32x4*)(Qg + (size_t)((tok0) + row) * 1024 + h * 128 + ch * 8); \
            sk[j_] = *(const u32x4*)(Kg + (size_t)((tok0) + row) * 1024 + h * 128 + ch * 8); } \
        _Pragma("unroll") for (int j_ = 0; j_ < 4; ++j_) { const int c = tid + 512 * j_, row = c >> 5, ch = c & 31; \
            sv[j_] = *(const u32x4*)(Vg + (size_t)((tok0) + row) * 2048 + h * 256 + ch * 8); } } while (0)
#define RET_WRITE() do { \
        _Pragma("unroll") for (int j_ = 0; j_ < 2; ++j_) { const int c = tid + 512 * j_, row = c >> 4, ch = c & 15; \
            if (!PRE) *(LAS u32x4*)(lds + R_QS + row * QS_STRIDE + ch * 16) = sq[j_]; \
            *(LAS u32x4*)(lds + R_KS + row * KS_STRIDE + ch * 16) = sk[j_]; } \
        _Pragma("unroll") for (int j_ = 0; j_ < 4; ++j_) { const int c = tid + 512 * j_, row = c >> 5, ch = c & 31; \
            *(LAS u32x4*)(lds + R_VS + row * VS_STRIDE + ch * 16) = sv[j_]; } } while (0)

    { const int tid = tid_in; RET_LOAD(tok_seg0); }
    for (int ci = 0; ci < 16; ++ci) {
        const int tok0 = tok_seg0 + 64 * ci;
        int tid_o = tid_in, lane_o = lane_in; asm volatile("" : "+v"(tid_o), "+v"(lane_o));
        const int tid = tid_o, lane = lane_o, r32 = lane & 31, hi = lane >> 5;
        const int trq = ((lane & 15) >> 2) + 8 * hi, trc = 16 * ((lane >> 4) & 1) + 4 * (lane & 3);
        const unsigned vaddr = ldsb + R_VS + trq * VS_STRIDE + (32 * wid + trc) * 2;
        const unsigned kaddr = ldsb + R_KS + trq * KS_STRIDE + trc * 2;
        RET_WRITE();
        __syncthreads();
        f32x16 o0, o1;
        if (!PRE) {
            if (wid < 4) {
                const int mt = wid >> 1, nt = wid & 1; f32x16 st;
#pragma unroll
                for (int r = 0; r < 16; ++r) st[r] = 0.f;
#pragma unroll
                for (int ks = 0; ks < 8; ++ks) {
                    const bf16x8 av = *(const LAS bf16x8*)(lds + R_KS + (32 * mt + r32) * KS_STRIDE + (16 * ks + 8 * hi) * 2);
                    const bf16x8 bv = *(const LAS bf16x8*)(lds + R_QS + (32 * nt + r32) * QS_STRIDE + (16 * ks + 8 * hi) * 2);
                    st = MFMA32(av, bv, st); }
                const int n = 32 * nt + r32;
#pragma unroll
                for (int gq = 0; gq < 4; ++gq) { float vv[4];
#pragma unroll
                    for (int i = 0; i < 4; ++i) { const int mm = 32 * mt + 8 * gq + 4 * hi + i; const int ex = (mm > n ? 2 * (mm - n) : 0) - 64;
                        vv[i] = st[4 * gq + i] * exp2f(l2g * (float)ex); }
                    u32x2 w; w.x = pk2(vv[0], vv[1]); w.y = pk2(vv[2], vv[3]);
                    *(LAS u32x2*)(lds + R_SS + n * SS_STRIDE + (32 * mt + 8 * gq + 4 * hi) * 2) = w; }
            }
#pragma unroll
            for (int r = 0; r < 16; ++r) { o0[r] = 0.f; o1[r] = 0.f; }
#pragma unroll
            for (int ks = 0; ks < 8; ++ks) {
                const bf16x8 av = *(const LAS bf16x8*)(lds + R_RT + (32 * wid + r32) * RT_STRIDE + (16 * ks + 8 * hi) * 2);
                const bf16x8 b0 = *(const LAS bf16x8*)(lds + R_QS + r32 * QS_STRIDE + (16 * ks + 8 * hi) * 2);
                const bf16x8 b1 = *(const LAS bf16x8*)(lds + R_QS + (32 + r32) * QS_STRIDE + (16 * ks + 8 * hi) * 2);
                o0 = MFMA32(av, b0, o0); o1 = MFMA32(av, b1, o1); }
            __syncthreads();
        }
        if (ci + 1 < 16) RET_LOAD(tok0 + 64);
        bf16x8 VF[4];
        { s16x4 l0 = trr(vaddr + 0 * 16 * VS_STRIDE), h0 = trr(vaddr + (0 * 16 + 4) * VS_STRIDE), l1 = trr(vaddr + 1 * 16 * VS_STRIDE), h1 = trr(vaddr + (1 * 16 + 4) * VS_STRIDE);
          s16x4 l2 = trr(vaddr + 2 * 16 * VS_STRIDE), h2 = trr(vaddr + (2 * 16 + 4) * VS_STRIDE), l3 = trr(vaddr + 3 * 16 * VS_STRIDE), h3 = trr(vaddr + (3 * 16 + 4) * VS_STRIDE);
          LDS_WAIT(); SBAR();
          VF[0] = RET_PK(l0, h0); VF[1] = RET_PK(l1, h1); VF[2] = RET_PK(l2, h2); VF[3] = RET_PK(l3, h3); }
        if (!PRE) {
#pragma unroll
            for (int ks = 0; ks < 4; ++ks) {
                const bf16x8 b0 = *(const LAS bf16x8*)(lds + R_SS + r32 * SS_STRIDE + (16 * ks + 8 * hi) * 2);
                const bf16x8 b1 = *(const LAS bf16x8*)(lds + R_SS + (32 + r32) * SS_STRIDE + (16 * ks + 8 * hi) * 2);
                o0 = MFMA32(VF[ks], b0, o0); o1 = MFMA32(VF[ks], b1, o1); }
        }
#pragma unroll
        for (int dt = 0; dt < 4; ++dt) {
            const unsigned ka = kaddr + 64 * dt;
            s16x4 l0 = trr(ka + 0 * 16 * KS_STRIDE), h0 = trr(ka + (0 * 16 + 4) * KS_STRIDE), l1 = trr(ka + 1 * 16 * KS_STRIDE), h1 = trr(ka + (1 * 16 + 4) * KS_STRIDE);
            s16x4 l2 = trr(ka + 2 * 16 * KS_STRIDE), h2 = trr(ka + (2 * 16 + 4) * KS_STRIDE), l3 = trr(ka + 3 * 16 * KS_STRIDE), h3 = trr(ka + (3 * 16 + 4) * KS_STRIDE);
#pragma unroll
            for (int r = 0; r < 16; ++r) R[dt][r] *= gc;
            LDS_WAIT(); SBAR();
            R[dt] = MFMA32(RET_PK(l0, h0), VF[0], R[dt]); R[dt] = MFMA32(RET_PK(l1, h1), VF[1], R[dt]);
            R[dt] = MFMA32(RET_PK(l2, h2), VF[2], R[dt]); R[dt] = MFMA32(RET_PK(l3, h3), VF[3], R[dt]);
        }
        if (!PRE) {
#pragma unroll
            for (int dt = 0; dt < 4; ++dt)
#pragma unroll
                for (int gq = 0; gq < 4; ++gq) { u32x2 w; w.x = pk2(R[dt][4 * gq], R[dt][4 * gq + 1]); w.y = pk2(R[dt][4 * gq + 2], R[dt][4 * gq + 3]);
                    *(LAS u32x2*)(lds + R_RT + (32 * wid + r32) * RT_STRIDE + (32 * dt + 8 * gq + 4 * hi) * 2) = w; }
            float a1 = 0.f, a2 = 0.f, b1 = 0.f, b2 = 0.f;
#pragma unroll
            for (int r = 0; r < 16; ++r) { a1 += o0[r]; a2 += o0[r] * o0[r]; b1 += o1[r]; b2 += o1[r] * o1[r]; }
            a1 += __shfl_xor(a1, 32); a2 += __shfl_xor(a2, 32); b1 += __shfl_xor(b1, 32); b2 += __shfl_xor(b2, 32);
            if (hi == 0) { *(LAS f32x2*)(lds + R_ST + (wid * 64 + r32) * 8) = (f32x2){a1, a2}; *(LAS f32x2*)(lds + R_ST + (wid * 64 + 32 + r32) * 8) = (f32x2){b1, b2}; }
            __syncthreads();
            u32x4 sgr[4];
#pragma unroll
            for (int j = 0; j < 4; ++j) { const int c = tid + 512 * j, n = c >> 5, e8 = (c & 31) * 8; sgr[j] = *(const u32x4*)(SGg + (size_t)(tok0 + n) * 2048 + h * 256 + e8); }
            float mu0, rs0, mu1, rs1;
            { float s1 = 0.f, s2 = 0.f, t1 = 0.f, t2 = 0.f;
#pragma unroll
              for (int w = 0; w < 8; ++w) { const f32x2 x = *(const LAS f32x2*)(lds + R_ST + (w * 64 + r32) * 8), y = *(const LAS f32x2*)(lds + R_ST + (w * 64 + 32 + r32) * 8); s1 += x.x; s2 += x.y; t1 += y.x; t2 += y.y; }
              mu0 = s1 * (1.0f / 256.0f); rs0 = 1.0f / sqrtf(fmaxf(s2 * (1.0f / 256.0f) - mu0 * mu0, 0.f) + RMS_EPS);
              mu1 = t1 * (1.0f / 256.0f); rs1 = 1.0f / sqrtf(fmaxf(t2 * (1.0f / 256.0f) - mu1 * mu1, 0.f) + RMS_EPS); }
#pragma unroll
            for (int gq = 0; gq < 4; ++gq) {
                u32x2 w0, w1;
                w0.x = pk2((o0[4 * gq] - mu0) * rs0, (o0[4 * gq + 1] - mu0) * rs0); w0.y = pk2((o0[4 * gq + 2] - mu0) * rs0, (o0[4 * gq + 3] - mu0) * rs0);
                w1.x = pk2((o1[4 * gq] - mu1) * rs1, (o1[4 * gq + 1] - mu1) * rs1); w1.y = pk2((o1[4 * gq + 2] - mu1) * rs1, (o1[4 * gq + 3] - mu1) * rs1);
                *(LAS u32x2*)(lds + R_OS + r32 * OS_STRIDE + (32 * wid + 8 * gq + 4 * hi) * 2) = w0;
                *(LAS u32x2*)(lds + R_OS + (32 + r32) * OS_STRIDE + (32 * wid + 8 * gq + 4 * hi) * 2) = w1; }
            __syncthreads();
#pragma unroll
            for (int j = 0; j < 4; ++j) { const int c = tid + 512 * j, n = c >> 5, e8 = (c & 31) * 8;
                const u32x4 ov = *(const LAS u32x4*)(lds + R_OS + n * OS_STRIDE + e8 * 2); const u32x4 gv = sgr[j]; u32x4 w;
#pragma unroll
                for (int q = 0; q < 4; ++q) w[q] = pk2(bf_lo(ov[q]) * bf_lo(gv[q]), bf_hi(ov[q]) * bf_hi(gv[q]));
                bf16_t* dstp = OUTg ? OUTg + (size_t)((tok0 + n) & rowmask) * 2048 : SGg + (size_t)(tok0 + n) * 2048;
                *(u32x4*)(dstp + h * 256 + e8) = w; }
        }
        __syncthreads();
    }
    if (PRE) {
        float* lp = Lbuf + ((size_t)(bh * 3 + g) * 8 + wid) * 4096 + lane_in;
#pragma unroll
        for (int dt = 0; dt < 4; ++dt)
#pragma unroll
            for (int r = 0; r < 16; ++r) lp[(dt * 16 + r) * 64] = R[dt][r];
    }
#undef RET_LOAD
#undef RET_WRITE
}
}

namespace att {
constexpr int KROW = 384, KBUF = 64 * KROW, VBUF = 16384;
constexpr int A_K = 0, A_V = 2 * KBUF, A_SCR = A_V + 2 * VBUF, A_END = A_SCR + 8 * 256;
static_assert(A_END <= LDS_BYTES, "attention LDS map");
__device__ __forceinline__ int koff(int row, int cb) { return row * KROW + (cb ^ ((row & 7) << 4)); }
__device__ __forceinline__ int v_st(int k, int c) { const int kk = (k & ~0xC) | ((k & 4) << 1) | ((k & 8) >> 1); return ((kk >> 3) * 4 + (c >> 5)) * 512 + ((kk & 7) * 32 + (c & 31)) * 2; }
__device__ __forceinline__ int v_rd_base(int lane) { return ((lane & 3) << 3) | (((lane >> 2) & 3) << 6) | (((lane >> 4) & 1) << 5) | (((lane >> 5) & 1) << 8); }
constexpr int v_rd_off(int d0, int ks, int half) { return d0 * 512 + ks * 4096 + half * 2048; }
template <int OFF> __device__ __forceinline__ s16x4 tr_read(int vb) { s16x4 r; asm volatile("ds_read_b64_tr_b16 %0, %1 offset:%2" : "=&v"(r) : "v"(vb), "i"(OFF) : "memory"); return r; }
template <int D0> __device__ __forceinline__ void pv_one(f32x16& od, int vb, bf16x8 pa0, bf16x8 pa1, bf16x8 pa2, bf16x8 pa3) {
    const s16x4 l0 = tr_read<v_rd_off(D0, 0, 0)>(vb), h0 = tr_read<v_rd_off(D0, 0, 1)>(vb), l1 = tr_read<v_rd_off(D0, 1, 0)>(vb), h1 = tr_read<v_rd_off(D0, 1, 1)>(vb);
    const s16x4 l2 = tr_read<v_rd_off(D0, 2, 0)>(vb), h2 = tr_read<v_rd_off(D0, 2, 1)>(vb), l3 = tr_read<v_rd_off(D0, 3, 0)>(vb), h3 = tr_read<v_rd_off(D0, 3, 1)>(vb);
    LDS_WAIT(); SBAR();
    __builtin_amdgcn_s_setprio(1);
    od = MFMA32(pa0, RET_PK(l0, h0), od); od = MFMA32(pa1, RET_PK(l1, h1), od); od = MFMA32(pa2, RET_PK(l2, h2), od); od = MFMA32(pa3, RET_PK(l3, h3), od);
    __builtin_amdgcn_s_setprio(0);
}

constexpr float ATT_THR = 11.5f;
__device__ __forceinline__ void partialSM(f32x16& p0, f32x16& p1, float& m_reg, float& mn, float& alpha) {
    float t8[8];
#pragma unroll
    for (int r = 0; r < 8; ++r) t8[r] = fmaxf(fmaxf(p0[r], p0[r + 8]), fmaxf(p1[r], p1[r + 8]));
    float pmax = fmaxf(fmaxf(fmaxf(t8[0], t8[1]), fmaxf(t8[2], t8[3])), fmaxf(fmaxf(t8[4], t8[5]), fmaxf(t8[6], t8[7])));
    { auto rr = __builtin_amdgcn_permlane32_swap(__float_as_uint(pmax), __float_as_uint(pmax), false, false); pmax = fmaxf(__uint_as_float(rr[0]), __uint_as_float(rr[1])); }
    if (__builtin_expect(__all(pmax - m_reg <= ATT_THR), 1)) { mn = m_reg; alpha = 1.f; }
    else { mn = fmaxf(m_reg, pmax); alpha = __builtin_amdgcn_exp2f(m_reg - mn); m_reg = mn; }
#pragma unroll
    for (int r = 0; r < 16; ++r) { p0[r] = p0[r] - mn; p1[r] = p1[r] - mn; }
#pragma unroll
    for (int r = 0; r < 16; ++r) p0[r] = __builtin_amdgcn_exp2f(p0[r]);
}
__device__ __forceinline__ void finishSM(f32x16& p0, f32x16& p1, float alpha, float& l_reg, bf16x8& pa0, bf16x8& pa1, bf16x8& pa2, bf16x8& pa3) {
#pragma unroll
    for (int r = 0; r < 16; ++r) p1[r] = __builtin_amdgcn_exp2f(p1[r]);
    float s8[8];
#pragma unroll
    for (int r = 0; r < 8; ++r) s8[r] = (p0[r] + p0[r + 8]) + (p1[r] + p1[r + 8]);
    float ps = ((s8[0] + s8[1]) + (s8[2] + s8[3])) + ((s8[4] + s8[5]) + (s8[6] + s8[7]));
    { auto rr = __builtin_amdgcn_permlane32_swap(__float_as_uint(ps), __float_as_uint(ps), false, false); ps = __uint_as_float(rr[0]) + __uint_as_float(rr[1]); }
    l_reg = l_reg * alpha + ps;
#define PK4(P, BASE, OUT) do { unsigned a0 = pk2(P[BASE + 0], P[BASE + 1]), a1 = pk2(P[BASE + 2], P[BASE + 3]);   \
    unsigned b0 = pk2(P[BASE + 4], P[BASE + 5]), b1 = pk2(P[BASE + 6], P[BASE + 7]);                              \
    auto r0 = __builtin_amdgcn_permlane32_swap(a0, b0, false, false); auto r1 = __builtin_amdgcn_permlane32_swap(a1, b1, false, false); \
    u32x4 w = {r0[0], r1[0], r0[1], r1[1]}; OUT = *reinterpret_cast<bf16x8*>(&w); } while (0)
    PK4(p0, 0, pa0); PK4(p0, 8, pa1); PK4(p1, 0, pa2); PK4(p1, 8, pa3);
#undef PK4
}
__device__ __forceinline__ void pv_all(f32x16 (&o)[4], int vb, bf16x8 pa0, bf16x8 pa1, bf16x8 pa2, bf16x8 pa3) {
    pv_one<0>(o[0], vb, pa0, pa1, pa2, pa3); pv_one<1>(o[1], vb, pa0, pa1, pa2, pa3); pv_one<2>(o[2], vb, pa0, pa1, pa2, pa3); pv_one<3>(o[3], vb, pa0, pa1, pa2, pa3);
}
constexpr int B_KN = 0, B_KR = 3 * 16384, B_V = B_KR + 3 * 8192, B_SCR = B_V + 3 * 16384, B_STG = B_SCR + 8 * 256, B_END = B_STG + 8 * 4608;
static_assert(B_END <= LDS_BYTES - 64, "attention v3 LDS map");
__device__ __forceinline__ void qkt3(f32x16& p0, f32x16& p1, const LAS unsigned char* Knb, const LAS unsigned char* Krb, const bf16x8 (&qr)[12], int r32, int hi, bool masked) {
#pragma unroll
    for (int r = 0; r < 16; ++r) { p0[r] = 0.f; p1[r] = 0.f; }
    const int x0 = (r32 & 15) << 4, rr0 = r32 * 256, rr1 = (32 + r32) * 256;
    __builtin_amdgcn_s_setprio(1);
#pragma unroll
    for (int d0 = 0; d0 < 8; ++d0) { const int cb = (d0 * 32 + hi * 16) ^ x0;
        const bf16x8 k0 = *(const LAS bf16x8*)(Knb + rr0 + cb), k1 = *(const LAS bf16x8*)(Knb + rr1 + cb);
        p0 = MFMA32(k0, qr[d0], p0); p1 = MFMA32(k1, qr[d0], p1); }
    const int y0 = ((r32 >> 1) & 7) << 4, qq0 = r32 * 128, qq1 = (32 + r32) * 128;
#pragma unroll
    for (int d0 = 0; d0 < 4; ++d0) { const int cb = (d0 * 32 + hi * 16) ^ y0;
        const bf16x8 k0 = *(const LAS bf16x8*)(Krb + qq0 + cb), k1 = *(const LAS bf16x8*)(Krb + qq1 + cb);
        p0 = MFMA32(k0, qr[8 + d0], p0); p1 = MFMA32(k1, qr[8 + d0], p1); }
    __builtin_amdgcn_s_setprio(0);
    if (masked) {
#pragma unroll
        for (int r = 0; r < 16; ++r) { p0[r] = -1e30f; p1[r] = -1e30f; } }
}
__device__ __forceinline__ void attn_unit3(LAS unsigned char* lds, const bf16_t* __restrict__ Q, const float* __restrict__ PQ, const f32x4* __restrict__ TB, const bf16_t* __restrict__ Kn, const bf16_t* __restrict__ Kr, const bf16_t* __restrict__ V2, bf16_t* SGA,
                                           int b, int h, int qb, int wid, int lane, bf16_t* OUTP, int rowmask) {
    const int r32 = lane & 31, hi = lane >> 5;
    const int R0 = b * SEQ + qb * 256, kb0 = b * SEQ, NT = 4 * qb + 4, jmax = 4 * qb + (wid >> 1);
    bf16x8 qr[12];
    { const int qrow = R0 + 32 * wid + r32; const bf16_t* qp = Q + (size_t)qrow * QROW + h * 192 + hi * 8;
      u32x4 qw[12];
#pragma unroll
      for (int d0 = 0; d0 < 12; ++d0) qw[d0] = *(const u32x4*)(qp + d0 * 16);
      const f32x4* pp = (const f32x4*)(PQ + (size_t)qrow * 12); const f32x4 s0 = pp[0], s1 = pp[1], s2 = pp[2];
      const float ss = ((s0[0] + s0[1]) + (s0[2] + s0[3])) + ((s1[0] + s1[1]) + (s1[2] + s1[3])) + ((s2[0] + s2[1]) + (s2[2] + s2[3]));
      const float rs = (1.0f / sqrtf(ss * (1.0f / 384.0f) + RMS_EPS)) * (0.07216878364870322f * 1.4426950408889634f);
#pragma unroll
      for (int d0 = 0; d0 < 8; ++d0) { u32x4 w;
#pragma unroll
          for (int q = 0; q < 4; ++q) w[q] = pk2(bf_lo(qw[d0][q]) * rs, bf_hi(qw[d0][q]) * rs);
          qr[d0] = *reinterpret_cast<bf16x8*>(&w); }
      const int pos = qrow & 4095;
#pragma unroll
      for (int i = 0; i < 2; ++i) {
          const f32x4* tp = TB + ((size_t)pos * 32 + 16 * i + 8 * hi) / 2; u32x4 w1, w2;
#pragma unroll
          for (int q = 0; q < 4; ++q) { const f32x4 t = tp[q];
              const float x1a = bf_lo(qw[8 + i][q]) * rs, x1b = bf_hi(qw[8 + i][q]) * rs, x2a = bf_lo(qw[10 + i][q]) * rs, x2b = bf_hi(qw[10 + i][q]) * rs;
              w1[q] = pk2(x1a * t[0] - x2a * t[1], x1b * t[2] - x2b * t[3]); w2[q] = pk2(x1a * t[1] + x2a * t[0], x1b * t[3] + x2b * t[2]); }
          qr[8 + i] = *reinterpret_cast<bf16x8*>(&w1); qr[10 + i] = *reinterpret_cast<bf16x8*>(&w2); }
    }
    asm volatile("s_waitcnt vmcnt(0)" ::: "memory");
    LAS float* al_l = (LAS float*)(lds + B_SCR + wid * 256); LAS float* li_l = al_l + 32;
    const int vb0 = (int)(unsigned)(size_t)(lds + B_V) + v_rd_base(lane);
    float m_reg = -1e30f, l_reg = 0.f; f32x16 o[4];
#pragma unroll
    for (int d = 0; d < 4; ++d)
#pragma unroll
        for (int r = 0; r < 16; ++r) o[d][r] = 0.f;
    unsigned okn[2], okr, ov[2];
#pragma unroll
    for (int i = 0; i < 2; ++i) {
        { const int row = (wid * 2 + i) * 4 + (lane >> 4), c = (lane & 15) ^ (row & 15); okn[i] = (unsigned)(row * 1024 + c * 8) * 2u; }
        { const int s = (wid * 2 + i) * 64 + lane, sub = s >> 5, t = s & 31, kk = (sub >> 2) * 8 + (t >> 2), k = (kk & ~0xC) | ((kk & 4) << 1) | ((kk & 8) >> 1), c = (sub & 3) * 32 + (t & 3) * 8;
          ov[i] = (unsigned)(k * 1024 + c) * 2u; }
    }
    { const int row = wid * 8 + (lane >> 3), c = (lane & 7) ^ ((row >> 1) & 7); okr = (unsigned)(row * 64 + c * 8) * 2u; }
    const char* KnT = (const char*)(Kn + (size_t)kb0 * 1024 + h * 128); const char* KrT = (const char*)(Kr + (size_t)kb0 * 64); const char* VT = (const char*)(V2 + (size_t)kb0 * 1024 + h * 128);
#define ATT_DMA(tile, buf) do { \
        const char* kn_ = KnT + (size_t)(tile) * (64 * 1024 * 2); const char* kr_ = KrT + (size_t)(tile) * (64 * 64 * 2); const char* v_ = VT + (size_t)(tile) * (64 * 1024 * 2); \
        __builtin_amdgcn_global_load_lds((const unsigned*)(kn_ + okn[0]), (LAS unsigned*)(lds + B_KN + (buf) * 16384 + (wid * 2 + 0) * 1024), 16, 0, 0); \
        __builtin_amdgcn_global_load_lds((const unsigned*)(kn_ + okn[1]), (LAS unsigned*)(lds + B_KN + (buf) * 16384 + (wid * 2 + 1) * 1024), 16, 0, 0); \
        __builtin_amdgcn_global_load_lds((const unsigned*)(kr_ + okr),    (LAS unsigned*)(lds + B_KR + (buf) * 8192 + wid * 1024), 16, 0, 0); \
        __builtin_amdgcn_global_load_lds((const unsigned*)(v_ + ov[0]),   (LAS unsigned*)(lds + B_V + (buf) * 16384 + (wid * 2 + 0) * 1024), 16, 0, 0); \
        __builtin_amdgcn_global_load_lds((const unsigned*)(v_ + ov[1]),   (LAS unsigned*)(lds + B_V + (buf) * 16384 + (wid * 2 + 1) * 1024), 16, 0, 0); } while (0)
#define RESC(a) do { if (__any((a) < 1.f)) { if (HI == 0) al_l[R32] = (a); LDS_WAIT(); \
        _Pragma("unroll") for (int r = 0; r < 16; ++r) { const float av = al_l[crow(r, HI)]; _Pragma("unroll") for (int d = 0; d < 4; ++d) o[d][r] *= av; } } } while (0)
    f32x16 pA0, pA1, pB0, pB1; float mnA, mnB, alA, alB; bf16x8 pa0, pa1, pa2, pa3;
    int lane_v = lane;
#define OPQ() asm volatile("" : "+v"(lane_v), "+v"(okn[0]), "+v"(okn[1]), "+v"(okr), "+v"(ov[0]), "+v"(ov[1]))
#define R32 (lane_v & 31)
#define HI (lane_v >> 5)
#define DMA_K(tile, buf) do { const char* kn_ = KnT + (size_t)(tile) * (64 * 1024 * 2); const char* kr_ = KrT + (size_t)(tile) * (64 * 64 * 2); \
        __builtin_amdgcn_global_load_lds((const unsigned*)(kn_ + okn[0]), (LAS unsigned*)(lds + B_KN + (buf) * 16384 + (wid * 2 + 0) * 1024), 16, 0, 0); \
        __builtin_amdgcn_global_load_lds((const unsigned*)(kn_ + okn[1]), (LAS unsigned*)(lds + B_KN + (buf) * 16384 + (wid * 2 + 1) * 1024), 16, 0, 0); \
        __builtin_amdgcn_global_load_lds((const unsigned*)(kr_ + okr),    (LAS unsigned*)(lds + B_KR + (buf) * 8192 + wid * 1024), 16, 0, 0); } while (0)
#define DMA_V(tile, buf) do { const char* v_ = VT + (size_t)(tile) * (64 * 1024 * 2); \
        __builtin_amdgcn_global_load_lds((const unsigned*)(v_ + ov[0]),   (LAS unsigned*)(lds + B_V + (buf) * 16384 + (wid * 2 + 0) * 1024), 16, 0, 0); \
        __builtin_amdgcn_global_load_lds((const unsigned*)(v_ + ov[1]),   (LAS unsigned*)(lds + B_V + (buf) * 16384 + (wid * 2 + 1) * 1024), 16, 0, 0); } while (0)
#define BAR_V(n) do { asm volatile("s_waitcnt vmcnt(" #n ") lgkmcnt(0)" ::: "memory"); __builtin_amdgcn_s_barrier(); asm volatile("" ::: "memory"); } while (0)
    DMA_K(0, 0); DMA_V(0, 0); DMA_K(1, 1);
    DMA_V(1, 1); DMA_K(2, 2);
    BAR_V(5);
    qkt3(pA0, pA1, lds + B_KN, lds + B_KR, qr, R32, HI, false); partialSM(pA0, pA1, m_reg, mnA, alA);
    BAR_V(5);
    int bp = 0, bc = 1, bn = 2;
    for (int j = 1; j + 1 < NT; j += 2) {
        OPQ(); SBAR(); DMA_V(j + 1, bn); DMA_K(j + 2, bp); SBAR();
        qkt3(pB0, pB1, lds + B_KN + bc * 16384, lds + B_KR + bc * 8192, qr, R32, HI, j > jmax);
        finishSM(pA0, pA1, alA, l_reg, pa0, pa1, pa2, pa3); SBAR();
        pv_all(o, vb0 + bp * 16384, pa0, pa1, pa2, pa3); partialSM(pB0, pB1, m_reg, mnB, alB);
        BAR_V(5); RESC(alB);
        { const int t_ = bp; bp = bc; bc = bn; bn = t_; }
        const bool more = (j + 3 < NT);
        OPQ(); SBAR(); DMA_V(j + 2, bn); if (more) DMA_K(j + 3, bp); SBAR();
        qkt3(pA0, pA1, lds + B_KN + bc * 16384, lds + B_KR + bc * 8192, qr, R32, HI, j + 1 > jmax);
        finishSM(pB0, pB1, alB, l_reg, pa0, pa1, pa2, pa3); SBAR();
        pv_all(o, vb0 + bp * 16384, pa0, pa1, pa2, pa3); partialSM(pA0, pA1, m_reg, mnA, alA);
        if (more) BAR_V(5); else BAR_V(2);
        RESC(alA);
        { const int t_ = bp; bp = bc; bc = bn; bn = t_; }
    }
    OPQ(); SBAR(); qkt3(pB0, pB1, lds + B_KN + bc * 16384, lds + B_KR + bc * 8192, qr, R32, HI, NT - 1 > jmax);
    finishSM(pA0, pA1, alA, l_reg, pa0, pa1, pa2, pa3); SBAR();
    pv_all(o, vb0 + bp * 16384, pa0, pa1, pa2, pa3); partialSM(pB0, pB1, m_reg, mnB, alB);
    BAR_V(0); RESC(alB);
    finishSM(pB0, pB1, alB, l_reg, pa0, pa1, pa2, pa3); SBAR();
    pv_all(o, vb0 + bc * 16384, pa0, pa1, pa2, pa3);
    if (hi == 0) li_l[r32] = l_reg;
    LDS_WAIT();
    float rl[16];
#pragma unroll
    for (int r = 0; r < 16; ++r) rl[r] = __builtin_amdgcn_rcpf(li_l[crow(r, hi)]);
    LAS unsigned char* stg = lds + B_STG + wid * 4608;
#pragma unroll
    for (int half = 0; half < 2; ++half) {
        u32x4 gv[4];
#pragma unroll
        for (int i = 0; i < 4; ++i) gv[i] = *(const u32x4*)(SGA + (size_t)(R0 + 32 * wid + (lane >> 3) + 8 * i) * 1024 + h * 128 + 64 * half + (lane & 7) * 8);
#pragma unroll
        for (int dd = 0; dd < 2; ++dd)
#pragma unroll
            for (int r = 0; r < 16; ++r) *(LAS bf16_t*)(stg + crow(r, hi) * 144 + (32 * dd + r32) * 2) = (bf16_t)(pk2(o[2 * half + dd][r] * rl[r], 0.f) & 0xffffu);
        LDS_WAIT();
#pragma unroll
        for (int i = 0; i < 4; ++i) { const u32x4 ov = *(const LAS u32x4*)(stg + ((lane >> 3) + 8 * i) * 144 + (lane & 7) * 16); u32x4 w;
#pragma unroll
            for (int q = 0; q < 4; ++q) w[q] = pk2(bf_lo(ov[q]) * bf_lo(gv[i][q]), bf_hi(ov[q]) * bf_hi(gv[i][q]));
            bf16_t* dstp = OUTP ? OUTP + (size_t)((R0 + 32 * wid + (lane >> 3) + 8 * i) & rowmask) * 1024 : SGA + (size_t)(R0 + 32 * wid + (lane >> 3) + 8 * i) * 1024;
            *(u32x4*)(dstp + h * 128 + 64 * half + (lane & 7) * 8) = w; }
        LDS_WAIT();
    }
    __syncthreads();
#undef ATT_DMA
#undef DMA_K
#undef DMA_V
#undef BAR_V
#undef RESC
#undef OPQ
#undef R32
#undef HI
}
}


#ifdef DBG_NAIVE_ATT
__device__ __forceinline__ void attn_naive_unit(LAS unsigned char* lds, const bf16_t* Q, const float* PQ, const f32x2* TB, const bf16_t* Kn, const bf16_t* Kr, const bf16_t* V2, bf16_t* SGA, int b, int h, int c, int tid) {
    LAS float* Qs = (LAS float*)lds;
    const int row = tid >> 3, part = tid & 7, tok = b * SEQ + c * 64 + row, pos = tok & 4095;
    float ss = 0.f; for (int i = 0; i < 12; ++i) ss += PQ[(size_t)tok * 12 + i];
    const float rs = (1.0f / sqrtf(ss * (1.0f / 384.0f) + RMS_EPS)) * 0.07216878364870322f;
    for (int i = 0; i < 16; ++i) { const int d = part + 8 * i; Qs[row * 193 + d] = bf1(Q[(size_t)tok * QROW + h * 192 + d]) * rs; }
    for (int i = 0; i < 4; ++i) { const int dd = part + 8 * i; const f32x2 cs = TB[pos * 32 + dd];
        const float x1 = bf1(Q[(size_t)tok * QROW + h * 192 + 128 + dd]) * rs, x2 = bf1(Q[(size_t)tok * QROW + h * 192 + 160 + dd]) * rs;
        Qs[row * 193 + 128 + dd] = x1 * cs.x - x2 * cs.y; Qs[row * 193 + 160 + dd] = x1 * cs.y + x2 * cs.x; }
    __syncthreads();
    float m = -1e30f, l = 0.f, acc[16];
    for (int i = 0; i < 16; ++i) acc[i] = 0.f;
    const int nk = 64 * (c + 1);
    for (int key = 0; key < nk; ++key) {
        const size_t kt = (size_t)(b * SEQ + key);
        float s = 0.f;
        for (int d = 0; d < 128; ++d) s += Qs[row * 193 + d] * bf1(Kn[kt * 1024 + h * 128 + d]);
        for (int d = 0; d < 64; ++d) s += Qs[row * 193 + 128 + d] * bf1(Kr[kt * 64 + d]);
        const float mn = fmaxf(m, s), al = __expf(m - mn), pe = __expf(s - mn); m = mn; l = l * al + pe;
        for (int i = 0; i < 16; ++i) acc[i] = acc[i] * al + pe * bf1(V2[kt * 1024 + h * 128 + part * 16 + i]);
    }
    for (int i = 0; i < 16; ++i) { bf16_t* op = SGA + (size_t)tok * 1024 + h * 128 + part * 16 + i; *op = (bf16_t)(pk2(acc[i] / l * bf1(*op), 0.f) & 0xffffu); }
    __syncthreads();
}
#endif
#define XB_TMO      128
#define XB_XCNT(j)  (256  + 64 * (j))
#define XB_XSUB(j)  (1280 + 64 * (j))
#define XB_XGEN(j)  (2304 + 64 * (j))
#define XB_TOP      3328
#define XB_TOPGEN   3392
#define XCD_BAR_WORDS 3456
#define XB_SPIN_CAP (1u << 24)

__device__ __forceinline__ unsigned xb_ld(unsigned* p)              { return __hip_atomic_load(p, __ATOMIC_RELAXED, __HIP_MEMORY_SCOPE_AGENT); }
__device__ __forceinline__ unsigned xb_add(unsigned* p, unsigned v) { return __hip_atomic_fetch_add(p, v, __ATOMIC_RELAXED, __HIP_MEMORY_SCOPE_AGENT); }
__device__ __forceinline__ unsigned xb_xcc_id() { return (unsigned)__builtin_amdgcn_s_getreg((3 << 11) | 20) & 0xFu; }
#define XB_SPIN(cond, bar) do { unsigned _sp = 0; while (cond) { __builtin_amdgcn_s_sleep(1); \
    if ((++_sp & 255u) == 0u) { if (xb_ld(&(bar)[XB_TMO])) break; if (_sp > XB_SPIN_CAP) { atomicAdd(&(bar)[XB_TMO], 1u); break; } } } } while (0)

struct XcdBarrier {
    unsigned* bar; unsigned x;
    volatile LAS unsigned* st;
};

__device__ __forceinline__ XcdBarrier xcd_barrier_post(unsigned* bar, volatile LAS unsigned* st, int tid) {
    XcdBarrier b; b.bar = bar; b.x = xb_xcc_id(); b.st = st;
    if (tid == 0) (void)xb_add(&bar[XB_XCNT(b.x)], 1u);
    return b;
}
__device__ __forceinline__ void xcd_barrier_complete(unsigned* bar, unsigned x, unsigned& nloc, unsigned& nx) {
    const unsigned G = gridDim.x * gridDim.y * gridDim.z;
    unsigned sum, cnt, mine, sp = 0u;
    for (;;) {
        sum = 0u; cnt = 0u; mine = 0u;
#pragma unroll
        for (unsigned j = 0; j < 16; ++j) { const unsigned c = xb_ld(&bar[XB_XCNT(j)]); sum += c; cnt += (c > 0u) ? 1u : 0u; mine = (j == x) ? c : mine; }
        if (sum == G) break;
        __builtin_amdgcn_s_sleep(1);
        if ((++sp & 255u) == 0u) { if (xb_ld(&bar[XB_TMO])) break; if (sp > XB_SPIN_CAP) { atomicAdd(&bar[XB_TMO], 1u); break; } }
    }
    nloc = mine > 0u ? mine : 1u; nx = cnt > 0u ? cnt : 1u;
}

__device__ __forceinline__ void xcd_barrier(const XcdBarrier& b, int tid) {
    asm volatile("s_waitcnt vmcnt(0)" ::: "memory");
    __syncthreads();
    if (tid == 0) {
        unsigned* bar = b.bar;
        __builtin_amdgcn_s_waitcnt(0);
        unsigned nloc = b.st[0], nx = b.st[1];
        if (nloc == 0u) { xcd_barrier_complete(bar, b.x, nloc, nx); b.st[0] = nloc; b.st[1] = nx; }
        const unsigned old = xb_add(&bar[XB_XSUB(b.x)], 1u);
        const unsigned gen = old / nloc;
        if (old + 1u == (gen + 1u) * nloc) {
            __builtin_amdgcn_fence(__ATOMIC_RELEASE, "agent");
            asm volatile("s_waitcnt vmcnt(0)" ::: "memory");
            const unsigned og = xb_add(&bar[XB_TOP], 1u);
            const unsigned tg = og / nx;
            if (og + 1u == (tg + 1u) * nx) xb_add(&bar[XB_TOPGEN], 1u);
            else XB_SPIN(xb_ld(&bar[XB_TOPGEN]) == tg, bar);
            __builtin_amdgcn_fence(__ATOMIC_ACQUIRE, "agent");
            xb_add(&bar[XB_XGEN(b.x)], 1u);
            asm volatile("s_waitcnt vmcnt(0)" ::: "memory");
        } else {
            XB_SPIN(xb_ld(&bar[XB_XGEN(b.x)]) == gen, bar);
            __builtin_amdgcn_fence(__ATOMIC_ACQUIRE, "agent");
            asm volatile("s_waitcnt vmcnt(0)" ::: "memory");
        }
    }
    __syncthreads();
}
__global__ void __launch_bounds__(NTHREADS, 2) yoco_fwd(Args args) {
    extern __shared__ __attribute__((aligned(16))) unsigned char lds_raw[];
    LAS unsigned char* lds = (LAS unsigned char*)lds_raw;
#ifdef CG_SEAM0
    cg::grid_group grid = cg::this_grid();
#endif
    const int wave = __builtin_amdgcn_readfirstlane(threadIdx.x >> 6);
#define PHASE_IDS() int lane_p; asm volatile("v_mbcnt_lo_u32_b32 %0, -1, 0\n\tv_mbcnt_hi_u32_b32 %0, -1, %0" : "=v"(lane_p)); const int lane = lane_p, tid = wave * 64 + lane; (void)tid; (void)lane
    const int G = gridDim.x, bx = blockIdx.x;
    const int vcu = (G % 8 == 0) ? (bx % 8) * (G / 8) + bx / 8 : bx;
    const int gw = vcu * NWAVES + wave, NGW = G * NWAVES;
    unsigned char* ws = args.ws;
    volatile LAS unsigned* MISC = (volatile LAS unsigned*)(lds + LDS_BYTES - 64);
    XcdBarrier bar;
    { PHASE_IDS(); if (tid < 16) MISC[tid] = 0u; __syncthreads(); bar = xcd_barrier_post((unsigned*)(ws + WS_CTL), MISC, tid); }
    const int lo = args.ph_lo, hi_ph = args.ph_hi;
#ifndef PH_MASK
#define PH_MASK 0x7ff
#endif
#ifndef DUP_PHASE
#define DUP_PHASE (-1)
#endif
#define IN(k) ((((PH_MASK) >> (k)) & 1) && lo <= (k) && (k) < hi_ph)
#ifdef CG_SEAM0
#define SEAM(k) do { if (IN(k) && IN((k) + 1)) { if ((k) == 0) grid.sync(); else { PHASE_IDS(); xcd_barrier(bar, tid); } } } while (0)
#else
#define SEAM(k) do { if (IN(k) && IN((k) + 1)) { PHASE_IDS(); xcd_barrier(bar, tid); } } while (0)
#endif
#define PHASE(k) if (IN(k)) for (int rep = 0; rep < ((DUP_PHASE) == (k) ? 2 : 1); ++rep)
#define DUPBAR() if (rep) xcd_barrier(bar, tid)
#define FIRST_OF_DUP(k) ((DUP_PHASE) == (k) && rep == 0)
    bf16_t* XN = (bf16_t*)(ws + WS_XN); bf16_t* Qb = (bf16_t*)(ws + WS_Q); bf16_t* Kb = (bf16_t*)(ws + WS_K); bf16_t* Vb = (bf16_t*)(ws + WS_V); bf16_t* SG = (bf16_t*)(ws + WS_G);
    float* Lb = (float*)(ws + WS_L);

    PHASE(0) { PHASE_IDS(); DUPBAR(); p0_prologue(args, lds, gw, NGW, wave, lane); }
    SEAM(0);
    PHASE(1) {
        PHASE_IDS(); DUPBAR();
#ifdef STAGGER_US
        { const unsigned long long t0 = __builtin_amdgcn_s_memrealtime(); const unsigned long long dl = (unsigned long long)(bx & 3) * (STAGGER_US) * 100ull;
          while (__builtin_amdgcn_s_memrealtime() - t0 < dl) __builtin_amdgcn_s_sleep(8); }
#endif
        pg8::Gemm g{XN, (const bf16_t*)(ws + WS_W1), MTOK, N1, DM}; pg8::StaticOrder S; S.init(MTOK, N1, G, bx);
        EpiP1 E{Qb, Kb, Vb, SG, (const f32x4*)(ws + WS_TABA)};
        pg8::gemm_phase<EpiP1, pg8::StaticOrder, true, true>(lds, g, S, E, tid);
    }
    SEAM(1);
    PHASE(2) { PHASE_IDS(); DUPBAR(); for (int it = bx; it < 192; it += G) ret::ret_item<true>(lds, Qb, Kb, Vb, SG, Lb, it / 3, it % 3, tid, wave, lane, nullptr, -1); }
    SEAM(2);
    PHASE(3) { PHASE_IDS(); DUPBAR(); for (int it = bx; it < 256; it += G) ret::ret_item<false>(lds, Qb, Kb, Vb, SG, Lb, it >> 2, it & 3, tid, wave, lane, FIRST_OF_DUP(3) ? XN : nullptr, 16383); }
    SEAM(3);
    PHASE(4) {
        PHASE_IDS(); DUPBAR();
        pg8::Gemm g{SG, (const bf16_t*)(ws + WS_W2), MTOK, DM, 2048}; pg8::StaticOrder S; S.init(MTOK, DM, G, bx);
        EpiPlain E{(bf16_t*)(ws + WS_Y1), DM};
        pg8::gemm_phase<EpiPlain, pg8::StaticOrder, true, true>(lds, g, S, E, tid);
    }
    SEAM(4);
    PHASE(5) { PHASE_IDS(); DUPBAR(); row_phase<false, true, true>((const bf16_t*)(ws + WS_Y1), args.in[0], args.in[5], (bf16_t*)(ws + WS_H1), (bf16_t*)(ws + WS_XN2), gw, NGW, lane); }
    SEAM(5);
    PHASE(6) {
        PHASE_IDS(); DUPBAR();
        pg8::Gemm g{(const bf16_t*)(ws + WS_XN2), (const bf16_t*)(ws + WS_W3), MTOK, N3, DM}; pg8::StaticOrder S; S.init(MTOK, N3, G, bx);
        EpiP4 E{(bf16_t*)(ws + WS_SG2), (bf16_t*)(ws + WS_CQ), (bf16_t*)(ws + WS_CKV), (float*)(ws + WS_KRR), (float*)(ws + WS_PQ), (float*)(ws + WS_PKV)};
        pg8::gemm_phase<EpiP4, pg8::StaticOrder, true, true>(lds, g, S, E, tid);
    }
    SEAM(6);
    PHASE(7) {
        PHASE_IDS(); DUPBAR();
        { const float* krr = (const float*)(ws + WS_KRR); bf16_t* kr = (bf16_t*)(ws + WS_KR); const f32x2* tB = (const f32x2*)(ws + WS_TABB);
          for (int i = gw * 64 + lane; i < MTOK * 32; i += NGW * 64) { const int row = i >> 5, dd = i & 31, pos = row & 4095; const f32x2 cs = tB[pos * 32 + dd];
              const float x1 = krr[(size_t)row * 64 + dd], x2 = krr[(size_t)row * 64 + 32 + dd];
              kr[(size_t)row * 64 + dd] = (bf16_t)(pk2(x1 * cs.x - x2 * cs.y, 0.f) & 0xffffu); kr[(size_t)row * 64 + 32 + dd] = (bf16_t)(pk2(x1 * cs.y + x2 * cs.x, 0.f) & 0xffffu); } }
        { pg8::Gemm g{(const bf16_t*)(ws + WS_CQ), (const bf16_t*)(ws + WS_WUQ), MTOK, QROW, 384}; pg8::StaticOrder S; S.init(MTOK, QROW, G, bx);
          EpiPlain E{(bf16_t*)(ws + WS_QM), QROW};
          pg8::gemm_phase<EpiPlain, pg8::StaticOrder, true, true>(lds, g, S, E, tid); }
        { pg8::Gemm g{(const bf16_t*)(ws + WS_CKV), (const bf16_t*)(ws + WS_WKV), MTOK, 2048, 256}; pg8::StaticOrder S; S.init(MTOK, 2048, G, bx);
          EpiP5kv E{(bf16_t*)(ws + WS_KN), (bf16_t*)(ws + WS_V2), (const float*)(ws + WS_PKV)};
          pg8::gemm_phase<EpiP5kv, pg8::StaticOrder, true, true>(lds, g, S, E, tid); }
    }
    SEAM(7);
    PHASE(8) {
        PHASE_IDS(); DUPBAR();
        const bf16_t* Qm = (const bf16_t*)(ws + WS_QM); const bf16_t* Kn = (const bf16_t*)(ws + WS_KN); const bf16_t* Kr = (const bf16_t*)(ws + WS_KR); const bf16_t* V2 = (const bf16_t*)(ws + WS_V2);
        bf16_t* SGA = (bf16_t*)(ws + WS_SG2);
#ifdef DBG_NAIVE_ATT
        for (int u = bx; u < 4096; u += G) attn_naive_unit(lds, Qm, (const float*)(ws + WS_PQ), (const f32x2*)(ws + WS_TABB), Kn, Kr, V2, SGA, u >> 9, (u >> 6) & 7, ((u & 63) + 5 * (u >> 8)) & 63, tid);
#else
        for (int i = 0;; ++i) {
            const int L = i * G + vcu; if (L >= 1024) break;
            int bhq, qb;
            if (G == 256) { const int j = vcu & 3; bhq = vcu >> 2; qb = (i == 0) ? 15 - j : (i == 1) ? 8 + j : (i == 2) ? 7 - j : j; }
            else { bhq = L >> 4; qb = 15 - (L & 15); }
            att::attn_unit3(lds, Qm, (const float*)(ws + WS_PQ), (const f32x4*)(ws + WS_TABB), Kn, Kr, V2, SGA, bhq >> 3, bhq & 7, qb, wave, lane, FIRST_OF_DUP(8) ? (bf16_t*)(ws + WS_CQ) : nullptr, 16383);
        }
#endif
    }
    SEAM(8);
    PHASE(9) {
        PHASE_IDS(); DUPBAR();
        pg8::Gemm g{(const bf16_t*)(ws + WS_SG2), (const bf16_t*)(ws + WS_W5), MTOK, DM, DM}; pg8::StaticOrder S; S.init(MTOK, DM, G, bx);
        EpiPlain E{(bf16_t*)(ws + WS_Y2), DM};
        pg8::gemm_phase<EpiPlain, pg8::StaticOrder, true, true>(lds, g, S, E, tid);
    }
    SEAM(9);
    PHASE(10) { PHASE_IDS(); DUPBAR(); row_phase<true, false, false>((const bf16_t*)(ws + WS_Y2), (const bf16_t*)(ws + WS_H1), args.in[16], args.out, nullptr, gw, NGW, lane); }
#undef IN
#undef SEAM
}

extern "C" void kernel_launch(void* const* d_in, const int* in_sizes, int n_in, void* d_out, int out_size, void* d_ws, size_t ws_size, hipStream_t stream) {
    static int grid = 0;
    if (!grid) {
        int dev = 0, cus = 0, per_cu = 0;
        if (n_in != 17 || out_size != MTOK * DM || ws_size < WS_NEED) { fprintf(stderr, "kernel_launch: unexpected shapes: n_in %d out %d ws %zu\n", n_in, out_size, ws_size); return; }
        (void)hipGetDevice(&dev);
        (void)hipDeviceGetAttribute(&cus, hipDeviceAttributeMultiprocessorCount, dev);
        (void)hipFuncSetAttribute((const void*)yoco_fwd, hipFuncAttributeMaxDynamicSharedMemorySize, LDS_BYTES);
        (void)hipOccupancyMaxActiveBlocksPerMultiprocessor(&per_cu, (const void*)yoco_fwd, NTHREADS, LDS_BYTES);
        if (per_cu < 1) { fprintf(stderr, "kernel_launch: occupancy query says %d blocks per CU\n", per_cu); }
        grid = cus > 0 ? cus : 256;
    }
    Args a{};
    for (int i = 0; i < 17; ++i) a.in[i] = (const float*)d_in[i];
    a.out = (float*)d_out; a.ws = (unsigned char*)d_ws; a.ph_lo = 0; a.ph_hi = 11;
    if (hipMemsetAsync((char*)d_ws + WS_CTL, 0, 65536, stream) != hipSuccess) { fprintf(stderr, "kernel_launch: memset failed\n"); return; }
    void* params[] = {&a};
    hipError_t e = hipLaunchCooperativeKernel((const void*)yoco_fwd, dim3(grid), dim3(NTHREADS), params, LDS_BYTES, stream);
    if (e != hipSuccess) fprintf(stderr, "kernel_launch: cooperative launch failed: %s (grid %d)\n", hipGetErrorString(e), grid);
}
```
